# Optimizing an MI355X kernel written in HIP

```python
import math
import jax, jax.numpy as jnp
from jax import lax
import numpy as np

D_MODEL = 1024
BATCH = 8
SEQ = 2048
DEPTH = 4
DEC_BATCH = 128
DEC_SEQ = 1
PAST_LEN = 16384
PAGE_SIZE = 128

N_EVEN = (DEPTH + 1) // 2
N_ODD = DEPTH // 2
HGRN_WIDTH = D_MODEL // 2
HGRN_EXPAND = 128
HGRN_HEADS = HGRN_WIDTH // HGRN_EXPAND
HGRN_DK = HGRN_EXPAND
HGRN_DV = HGRN_WIDTH // HGRN_HEADS
HGRN_CHUNK = 64
CONF_WIDTH = D_MODEL - HGRN_WIDTH
CONF_KERNEL = 31
SC_WIDTH = D_MODEL
SC_KERNEL = 3
D_FF = 256 * math.ceil(8 * D_MODEL / 3 / 256)
EVEN_IN = 4 * HGRN_WIDTH + 2 * CONF_WIDTH
ALPHA = (2 * DEPTH) ** 0.25
BETA = (8 * DEPTH) ** -0.25
LN_EPS = 1e-5
RMS_EPS = 1e-6

kernel_name = "hgrn2_conformer_shortconv_hybrid_step"


def _layernorm(x, w, b):
    xf = x.astype(jnp.float32)
    mu = jnp.mean(xf, axis=-1, keepdims=True)
    var = jnp.mean(jnp.square(xf - mu), axis=-1, keepdims=True)
    return ((xf - mu) * lax.rsqrt(var + LN_EPS) * w.astype(jnp.float32) + b.astype(jnp.float32)).astype(x.dtype)


def _causal_dwconv(u_ext, w):
    c = u_ext.shape[-1]
    return lax.conv_general_dilated(u_ext, w.astype(u_ext.dtype)[:, None, :], window_strides=(1,), padding='VALID',
                                    dimension_numbers=('NWC', 'WIO', 'NWC'), feature_group_count=c)


def _hgrn2_recurrence(q, k, v, g, s0):
    bsz, t_len, n_h = q.shape[:3]
    L = math.gcd(t_len, HGRN_CHUNK)
    n = t_len // L

    def to_chunks(a):
        return a.reshape(bsz, n, L, n_h, a.shape[-1]).transpose(1, 0, 3, 2, 4)

    tri = jnp.tril(jnp.ones((L, L), dtype=bool))

    def step(S, inp):
        qc, kc, vc, gc = inp
        b = jnp.cumsum(gc, axis=2)
        o = jnp.einsum('bhtk,bhkv->bhtv', qc * jnp.exp(b), S)
        diff = b[:, :, :, None, :] - b[:, :, None, :, :]
        decay = jnp.exp(jnp.where(tri[:, :, None], diff, -jnp.inf))
        scores = jnp.einsum('bhtk,bhsk,bhtsk->bhts', qc, kc, decay)
        o = o + jnp.einsum('bhts,bhsv->bhtv', scores, vc)
        b_last = b[:, :, -1:, :]
        S = jnp.exp(b_last[:, :, 0, :, None]) * S + jnp.einsum('bhsk,bhsv->bhkv', kc * jnp.exp(b_last - b), vc)
        return S, o

    s_final, o = lax.scan(step, s0.astype(jnp.float32), (to_chunks(q), to_chunks(k), to_chunks(v), to_chunks(g)))
    o = o.transpose(1, 0, 3, 2, 4).reshape(bsz, t_len, n_h, v.shape[-1])
    return o, s_final


def _even_mixer(x, s0, conf_buf, w_in, w_out, lb, gnorm_w, dw_w, dw_b, cln_w, cln_b):
    bsz, t_len, _ = x.shape
    f32 = jnp.float32
    p = x @ w_in
    hw = HGRN_WIDTH
    zq = p[..., 0:hw]
    zf = p[..., hw:2 * hw]
    vi = p[..., 2 * hw:3 * hw]
    zg = p[..., 3 * hw:4 * hw]
    ca = p[..., 4 * hw:4 * hw + CONF_WIDTH]
    cg = p[..., 4 * hw + CONF_WIDTH:]
    zf32 = zf.astype(f32)
    lb = lb.astype(f32)
    logf = jnp.logaddexp(jnp.log(lb), jnp.log1p(-lb) + jax.nn.log_sigmoid(zf32))
    kk = (1.0 - lb) * jax.nn.sigmoid(-zf32)
    qq = jax.nn.silu(zq.astype(f32)) * (HGRN_DK ** -0.5)
    shp_k = (bsz, t_len, HGRN_HEADS, HGRN_DK)
    o, s_new = _hgrn2_recurrence(qq.reshape(shp_k), kk.reshape(shp_k),
                                 vi.astype(f32).reshape(bsz, t_len, HGRN_HEADS, HGRN_DV),
                                 logf.reshape(shp_k), s0)
    o = o * lax.rsqrt(jnp.mean(jnp.square(o), axis=-1, keepdims=True) + RMS_EPS) * gnorm_w.astype(f32)
    o = o.reshape(bsz, t_len, HGRN_WIDTH) * jax.nn.silu(zg.astype(f32))
    u = ca * jax.nn.sigmoid(cg)
    u_ext = jnp.concatenate([conf_buf.astype(u.dtype), u], axis=1)
    c = _causal_dwconv(u_ext, dw_w) + dw_b
    c = jax.nn.silu(_layernorm(c, cln_w, cln_b))
    y = jnp.concatenate([o.astype(x.dtype), c.astype(x.dtype)], axis=-1) @ w_out
    return y, s_new.astype(s0.dtype), u_ext[:, -(CONF_KERNEL - 1):].astype(conf_buf.dtype)


def _odd_mixer(x, sc_buf, w_in, conv_w, w_out):
    p = x @ w_in
    bg = p[..., :SC_WIDTH]
    cg = p[..., SC_WIDTH:2 * SC_WIDTH]
    xv = p[..., 2 * SC_WIDTH:]
    z = cg * xv
    z_ext = jnp.concatenate([sc_buf.astype(z.dtype), z], axis=1)
    y = bg * _causal_dwconv(z_ext, conv_w)
    return y @ w_out, z_ext[:, -(SC_KERNEL - 1):].astype(sc_buf.dtype)


def _swiglu(x, w1, w3, w2):
    return (jax.nn.silu(x @ w1) * (x @ w3)) @ w2


def _trunk(x, s_hgrn, s_conf, s_sconv, lbs, w_in_even, w_out_even, hgrn_gnorm_w, conf_dw_w, conf_dw_b,
           conf_ln_w, conf_ln_b, sc_w_in, sc_conv_w, sc_w_out, ffn_w1, ffn_w3, ffn_w2,
           ln_mix_w, ln_mix_b, ln_ffn_w, ln_ffn_b):
    new_h, new_c, new_s = [], [], []
    for l in range(DEPTH):
        if l % 2 == 0:
            e = l // 2
            m, sh, cb = _even_mixer(x, s_hgrn[e], s_conf[e], w_in_even[e], w_out_even[e], lbs[e],
                                    hgrn_gnorm_w[e], conf_dw_w[e], conf_dw_b[e], conf_ln_w[e], conf_ln_b[e])
            new_h.append(sh)
            new_c.append(cb)
        else:
            o = l // 2
            m, sb = _odd_mixer(x, s_sconv[o], sc_w_in[o], sc_conv_w[o], sc_w_out[o])
            new_s.append(sb)
        x = _layernorm(ALPHA * x + m, ln_mix_w[l], ln_mix_b[l])
        x = _layernorm(ALPHA * x + _swiglu(x, ffn_w1[l], ffn_w3[l], ffn_w2[l]), ln_ffn_w[l], ln_ffn_b[l])
    return x, jnp.stack(new_h), jnp.stack(new_c), jnp.stack(new_s)


def setup_inputs(seed: int = 0) -> dict:
    key = jax.random.key(seed)
    ks = jax.random.split(key, 32)
    nrm = lambda k, shp, s: jax.random.normal(k, shp, jnp.float32) * s
    d = D_MODEL
    even_col_scale = jnp.concatenate([
        jnp.ones((2 * HGRN_WIDTH,)), jnp.full((HGRN_WIDTH,), BETA), jnp.ones((HGRN_WIDTH,)),
        jnp.full((CONF_WIDTH,), BETA), jnp.ones((CONF_WIDTH,))]).astype(jnp.float32)
    sc_col_scale = jnp.concatenate([jnp.ones((2 * SC_WIDTH,)), jnp.full((SC_WIDTH,), BETA)]).astype(jnp.float32)
    return {
        "x_prompt": nrm(ks[0], (BATCH, SEQ, d), 1.0),
        "x_sample": nrm(ks[1], (DEC_BATCH, DEC_SEQ, d), 1.0),
        "state_hgrn": nrm(ks[2], (N_EVEN, DEC_BATCH, HGRN_HEADS, HGRN_DK, HGRN_DV), 0.3),
        "state_conf": nrm(ks[3], (N_EVEN, DEC_BATCH, CONF_KERNEL - 1, CONF_WIDTH), 0.5),
        "state_sconv": nrm(ks[4], (N_ODD, DEC_BATCH, SC_KERNEL - 1, SC_WIDTH), 0.5),
        "w_in_even": nrm(ks[5], (N_EVEN, d, EVEN_IN), d ** -0.5) * even_col_scale,
        "w_out_even": nrm(ks[6], (N_EVEN, HGRN_WIDTH + CONF_WIDTH, d), (HGRN_WIDTH + CONF_WIDTH) ** -0.5 * BETA),
        "hgrn_lb_logits": nrm(ks[7], (N_EVEN, HGRN_WIDTH), 0.1),
        "hgrn_gnorm_w": 1.0 + nrm(ks[8], (N_EVEN, HGRN_DV), 0.05),
        "conf_dw_w": nrm(ks[9], (N_EVEN, CONF_KERNEL, CONF_WIDTH), CONF_KERNEL ** -0.5),
        "conf_dw_b": nrm(ks[10], (N_EVEN, CONF_WIDTH), 0.02),
        "conf_ln_w": 1.0 + nrm(ks[11], (N_EVEN, CONF_WIDTH), 0.05),
        "conf_ln_b": nrm(ks[12], (N_EVEN, CONF_WIDTH), 0.02),
        "sc_w_in": nrm(ks[13], (N_ODD, d, 3 * SC_WIDTH), d ** -0.5) * sc_col_scale,
        "sc_conv_w": nrm(ks[14], (N_ODD, SC_KERNEL, SC_WIDTH), SC_KERNEL ** -0.5),
        "sc_w_out": nrm(ks[15], (N_ODD, SC_WIDTH, d), SC_WIDTH ** -0.5 * BETA),
        "ffn_w1": nrm(ks[16], (DEPTH, d, D_FF), d ** -0.5),
        "ffn_w3": nrm(ks[17], (DEPTH, d, D_FF), d ** -0.5 * BETA),
        "ffn_w2": nrm(ks[18], (DEPTH, D_FF, d), D_FF ** -0.5 * BETA),
        "ln_mix_w": 1.0 + nrm(ks[19], (DEPTH, d), 0.05),
        "ln_mix_b": nrm(ks[20], (DEPTH, d), 0.02),
        "ln_ffn_w": 1.0 + nrm(ks[21], (DEPTH, d), 0.05),
        "ln_ffn_b": nrm(ks[22], (DEPTH, d), 0.02),
    }


def reference(x_prompt, x_sample, state_hgrn, state_conf, state_sconv, w_in_even, w_out_even, hgrn_lb_logits,
              hgrn_gnorm_w, conf_dw_w, conf_dw_b, conf_ln_w, conf_ln_b, sc_w_in, sc_conv_w, sc_w_out,
              ffn_w1, ffn_w3, ffn_w2, ln_mix_w, ln_mix_b, ln_ffn_w, ln_ffn_b):
    lbs = jnp.cumsum(jax.nn.softmax(hgrn_lb_logits.astype(jnp.float32), axis=0), axis=0)
    lbs = lbs - lbs[0:1]
    weights = (w_in_even, w_out_even, hgrn_gnorm_w, conf_dw_w, conf_dw_b, conf_ln_w, conf_ln_b,
               sc_w_in, sc_conv_w, sc_w_out, ffn_w1, ffn_w3, ffn_w2, ln_mix_w, ln_mix_b, ln_ffn_w, ln_ffn_b)
    zh = jnp.zeros((N_EVEN, BATCH, HGRN_HEADS, HGRN_DK, HGRN_DV), state_hgrn.dtype)
    zc = jnp.zeros((N_EVEN, BATCH, CONF_KERNEL - 1, CONF_WIDTH), state_conf.dtype)
    zs = jnp.zeros((N_ODD, BATCH, SC_KERNEL - 1, SC_WIDTH), state_sconv.dtype)
    y_prompt, h_p, c_p, s_p = _trunk(x_prompt, zh, zc, zs, lbs, *weights)
    y_sample, h_s, c_s, s_s = _trunk(x_sample, state_hgrn, state_conf, state_sconv, lbs, *weights)
    return (y_prompt, y_sample, h_p, c_p, s_p, h_s, c_s, s_s)
```

```cpp
#include <hip/hip_runtime.h>
#include <math.h>

namespace {
constexpr int D = 1024, NB = 8, SEQ = 2048, DEC = 128, MP = NB * SEQ, MT = MP + DEC;
constexpr int HW = 512, NH = 4, DK = 128, DV = 128, CW = 512, CK = 31, DFF = 2816, EIN = 3072;
constexpr float ALPHA = 1.6817928305074292f, LN_EPS = 1e-5f, RMS_EPS = 1e-6f;

__device__ __forceinline__ float sigmoidf_(float x) { return 1.f / (1.f + expf(-x)); }
__device__ __forceinline__ float siluf_(float x) { return x / (1.f + expf(-x)); }

template <int MODE>
__global__ __launch_bounds__(256) void sgemm128(const float* __restrict__ A, int lda, const float* __restrict__ W, int ldw, float* C, int ldc, int K) {
    __shared__ float As[8][132];
    __shared__ float Bs[8][128];
    const int tid = threadIdx.x, bm = blockIdx.y * 128, bn = blockIdx.x * 128, tx = tid & 15, ty = tid >> 4;
    float acc[8][8];
#pragma unroll
    for (int i = 0; i < 8; ++i)
#pragma unroll
        for (int j = 0; j < 8; ++j) acc[i][j] = 0.f;
    for (int k0 = 0; k0 < K; k0 += 8) {
        const float4 a = *(const float4*)(A + (size_t)(bm + (tid >> 1)) * lda + k0 + (tid & 1) * 4);
        const float4 b = *(const float4*)(W + (size_t)(k0 + (tid >> 5)) * ldw + bn + (tid & 31) * 4);
        __syncthreads();
        As[(tid & 1) * 4 + 0][tid >> 1] = a.x; As[(tid & 1) * 4 + 1][tid >> 1] = a.y; As[(tid & 1) * 4 + 2][tid >> 1] = a.z; As[(tid & 1) * 4 + 3][tid >> 1] = a.w;
        *(float4*)&Bs[tid >> 5][(tid & 31) * 4] = b;
        __syncthreads();
#pragma unroll
        for (int kk = 0; kk < 8; ++kk) {
            float av[8], bv[8];
            const float4 a0 = *(const float4*)&As[kk][ty * 4], a1 = *(const float4*)&As[kk][64 + ty * 4];
            const float4 b0 = *(const float4*)&Bs[kk][tx * 4], b1 = *(const float4*)&Bs[kk][64 + tx * 4];
            av[0] = a0.x; av[1] = a0.y; av[2] = a0.z; av[3] = a0.w; av[4] = a1.x; av[5] = a1.y; av[6] = a1.z; av[7] = a1.w;
            bv[0] = b0.x; bv[1] = b0.y; bv[2] = b0.z; bv[3] = b0.w; bv[4] = b1.x; bv[5] = b1.y; bv[6] = b1.z; bv[7] = b1.w;
#pragma unroll
            for (int i = 0; i < 8; ++i)
#pragma unroll
                for (int j = 0; j < 8; ++j) acc[i][j] = fmaf(av[i], bv[j], acc[i][j]);
        }
    }
#pragma unroll
    for (int i = 0; i < 8; ++i) {
        const int r = bm + (i < 4 ? ty * 4 + i : 64 + ty * 4 + i - 4);
#pragma unroll
        for (int j = 0; j < 8; ++j) {
            const int c = bn + (j < 4 ? tx * 4 + j : 64 + tx * 4 + j - 4);
            float* p = C + (size_t)r * ldc + c;
            if (MODE == 0) *p = acc[i][j]; else *p = siluf_(*p) * acc[i][j];
        }
    }
}

__global__ void k_lbs(const float* logits, float* lbs) {
    const int c = blockIdx.x * blockDim.x + threadIdx.x; if (c >= HW) return;
    const float l0 = logits[c], l1 = logits[HW + c], m = fmaxf(l0, l1), e0 = expf(l0 - m), e1 = expf(l1 - m);
    lbs[c] = 0.f; lbs[HW + c] = e1 / (e0 + e1);
}

__global__ __launch_bounds__(256) void k_hgrn_seq(const float* __restrict__ P, int row0, int T, const float* __restrict__ S0, const float* __restrict__ lb, float* __restrict__ A2, float* __restrict__ Snew) {
    __shared__ float red[16][17];
    const int tid = threadIdx.x, v = tid & 15, kg = tid >> 4;
    const int vs = blockIdx.x & 7, h = (blockIdx.x >> 3) & 3, b = blockIdx.x >> 5;
    float S[8], lbk[8];
    const size_t sbase = (((size_t)b * NH + h) * DK) * DV + vs * 16 + v;
#pragma unroll
    for (int j = 0; j < 8; ++j) { S[j] = S0 ? S0[sbase + (size_t)(kg * 8 + j) * DV] : 0.f; lbk[j] = lb[h * DK + kg * 8 + j]; }
    for (int t = 0; t < T; ++t) {
        const float* pr = P + (size_t)(row0 + b * T + t) * EIN;
        const float vv = pr[2 * HW + h * DV + vs * 16 + v];
        float part = 0.f;
#pragma unroll
        for (int j = 0; j < 8; ++j) {
            const int k = h * DK + kg * 8 + j;
            const float zq = pr[k], zf = pr[HW + k];
            const float sg = sigmoidf_(zf), f = lbk[j] + (1.f - lbk[j]) * sg, kk = (1.f - lbk[j]) * (1.f - sg);
            const float qq = siluf_(zq) * 0.08838834764831845f;
            S[j] = f * S[j] + kk * vv;
            part += S[j] * qq;
        }
        red[kg][v] = part;
        __syncthreads();
        if (tid < 16) { float s = 0.f;
#pragma unroll
            for (int g = 0; g < 16; ++g) s += red[g][tid];
            A2[(size_t)(row0 + b * T + t) * D + h * DV + vs * 16 + tid] = s; }
        __syncthreads();
    }
#pragma unroll
    for (int j = 0; j < 8; ++j) Snew[sbase + (size_t)(kg * 8 + j) * DV] = S[j];
}
__global__ __launch_bounds__(512) void k_hgrn_post(const float* __restrict__ P, int row0, const float* __restrict__ gw, float* __restrict__ A2) {
    __shared__ float ws[8];
    const int row = row0 + blockIdx.x, tid = threadIdx.x, v = tid & 127;
    const float o = A2[(size_t)row * D + tid];
    float s = o * o;
    for (int d = 32; d >= 1; d >>= 1) s += __shfl_xor(s, d);
    if ((tid & 63) == 0) ws[tid >> 6] = s;
    __syncthreads();
    const float tot = ws[(tid >> 7) * 2] + ws[(tid >> 7) * 2 + 1];
    const float zg = P[(size_t)row * EIN + 3 * HW + tid];
    A2[(size_t)row * D + tid] = o * rsqrtf(tot * (1.f / DV) + RMS_EPS) * gw[v] * siluf_(zg);
}
__global__ __launch_bounds__(512) void k_conf(const float* __restrict__ P, int row0, int T, const float* __restrict__ cbuf, const float* __restrict__ dww, const float* __restrict__ dwb,
                                              const float* __restrict__ lnw, const float* __restrict__ lnb, float* __restrict__ A2, float* __restrict__ newc) {
    __shared__ float ws[8], ws2[8];
    const int b = blockIdx.x / T, t = blockIdx.x % T, ch = threadIdx.x, tid = threadIdx.x;
    float acc = dwb[ch];
    for (int j = 0; j < CK; ++j) {
        const int i = t + j;
        float u;
        if (i < CK - 1) u = cbuf ? cbuf[((size_t)b * (CK - 1) + i) * CW + ch] : 0.f;
        else { const float* pr = P + (size_t)(row0 + b * T + (i - (CK - 1))) * EIN; u = pr[4 * HW + ch] * sigmoidf_(pr[4 * HW + CW + ch]); }
        acc += dww[j * CW + ch] * u;
    }
    float s = acc;
    for (int d = 32; d >= 1; d >>= 1) s += __shfl_xor(s, d);
    if ((tid & 63) == 0) ws[tid >> 6] = s;
    __syncthreads();
    float mean = 0.f;
    for (int i = 0; i < 8; ++i) mean += ws[i];
    mean *= (1.f / CW);
    const float dlt = acc - mean;
    float q = dlt * dlt;
    for (int d = 32; d >= 1; d >>= 1) q += __shfl_xor(q, d);
    if ((tid & 63) == 0) ws2[tid >> 6] = q;
    __syncthreads();
    float var = 0.f;
    for (int i = 0; i < 8; ++i) var += ws2[i];
    var *= (1.f / CW);
    const float c = dlt * rsqrtf(var + LN_EPS) * lnw[ch] + lnb[ch];
    A2[(size_t)(row0 + b * T + t) * D + HW + ch] = siluf_(c);
    const int io = (CK - 1) + t - T;
    if (io >= 0) { const float* pr = P + (size_t)(row0 + b * T + t) * EIN; newc[((size_t)b * (CK - 1) + io) * CW + ch] = pr[4 * HW + ch] * sigmoidf_(pr[4 * HW + CW + ch]); }
    if (t == 0 && T < CK - 1) { for (int i = 0; i < CK - 1 - T; ++i) newc[((size_t)b * (CK - 1) + i) * CW + ch] = cbuf[((size_t)b * (CK - 1) + T + i) * CW + ch]; }
}
__global__ __launch_bounds__(1024) void k_sconv(const float* __restrict__ P, int row0, int T, const float* __restrict__ sbuf, const float* __restrict__ cw, float* __restrict__ A2, float* __restrict__ news) {
    const int b = blockIdx.x / T, t = blockIdx.x % T, ch = threadIdx.x;
    float conv = 0.f, zcur = 0.f;
    for (int j = 0; j < 3; ++j) {
        const int i = t + j; float z;
        if (i < 2) z = sbuf ? sbuf[((size_t)b * 2 + i) * D + ch] : 0.f;
        else { const float* pr = P + (size_t)(row0 + b * T + (i - 2)) * EIN; z = pr[D + ch] * pr[2 * D + ch]; }
        conv += cw[j * D + ch] * z;
        if (j == 2) zcur = z;
    }
    const float bg = P[(size_t)(row0 + b * T + t) * EIN + ch];
    A2[(size_t)(row0 + b * T + t) * D + ch] = bg * conv;
    const int io = 2 + t - T;
    if (io >= 0) news[((size_t)b * 2 + io) * D + ch] = zcur;
    if (t == 0 && T < 2) { for (int i = 0; i < 2 - T; ++i) news[((size_t)b * 2 + i) * D + ch] = sbuf[((size_t)b * 2 + T + i) * D + ch]; }
}
__global__ __launch_bounds__(256) void k_ln_res(float* __restrict__ X, const float* __restrict__ Mv, const float* __restrict__ w, const float* __restrict__ bb) {
    __shared__ float ws[4], ws2[4];
    const int row = blockIdx.x, tid = threadIdx.x;
    const float4 x = *(const float4*)(X + (size_t)row * D + tid * 4), m = *(const float4*)(Mv + (size_t)row * D + tid * 4);
    float z[4] = {ALPHA * x.x + m.x, ALPHA * x.y + m.y, ALPHA * x.z + m.z, ALPHA * x.w + m.w};
    float s = (z[0] + z[1]) + (z[2] + z[3]);
    for (int d = 32; d >= 1; d >>= 1) s += __shfl_xor(s, d);
    if ((tid & 63) == 0) ws[tid >> 6] = s;
    __syncthreads();
    const float mean = (ws[0] + ws[1] + ws[2] + ws[3]) * (1.f / D);
    float q = 0.f;
    for (int i = 0; i < 4; ++i) { z[i] -= mean; q += z[i] * z[i]; }
    for (int d = 32; d >= 1; d >>= 1) q += __shfl_xor(q, d);
    if ((tid & 63) == 0) ws2[tid >> 6] = q;
    __syncthreads();
    const float rstd = rsqrtf((ws2[0] + ws2[1] + ws2[2] + ws2[3]) * (1.f / D) + LN_EPS);
    const float4 wv = *(const float4*)(w + tid * 4), bv = *(const float4*)(bb + tid * 4);
    float4 o; o.x = z[0] * rstd * wv.x + bv.x; o.y = z[1] * rstd * wv.y + bv.y; o.z = z[2] * rstd * wv.z + bv.z; o.w = z[3] * rstd * wv.w + bv.w;
    *(float4*)(X + (size_t)row * D + tid * 4) = o;
}
}

extern "C" void kernel_launch(void* const* d_in, const int* in_sizes, int n_in, void* d_out, int out_size, void* d_ws, size_t ws_size, hipStream_t stream) {
    const float* x_prompt = (const float*)d_in[0]; const float* x_sample = (const float*)d_in[1];
    const float* state_hgrn = (const float*)d_in[2]; const float* state_conf = (const float*)d_in[3]; const float* state_sconv = (const float*)d_in[4];
    const float* w_in_even = (const float*)d_in[5]; const float* w_out_even = (const float*)d_in[6]; const float* lb_logits = (const float*)d_in[7];
    const float* gnorm_w = (const float*)d_in[8]; const float* dw_w = (const float*)d_in[9]; const float* dw_b = (const float*)d_in[10];
    const float* cln_w = (const float*)d_in[11]; const float* cln_b = (const float*)d_in[12]; const float* sc_w_in = (const float*)d_in[13];
    const float* sc_conv_w = (const float*)d_in[14]; const float* sc_w_out = (const float*)d_in[15]; const float* ffn_w1 = (const float*)d_in[16];
    const float* ffn_w3 = (const float*)d_in[17]; const float* ffn_w2 = (const float*)d_in[18]; const float* ln_mix_w = (const float*)d_in[19];
    const float* ln_mix_b = (const float*)d_in[20]; const float* ln_ffn_w = (const float*)d_in[21]; const float* ln_ffn_b = (const float*)d_in[22];
    float* out = (float*)d_out;
    float* X = out;
    float* o_hp = out + (size_t)MT * D;
    float* o_cp = o_hp + (size_t)2 * NB * NH * DK * DV;
    float* o_sp = o_cp + (size_t)2 * NB * 30 * CW;
    float* o_hs = o_sp + (size_t)2 * NB * 2 * D;
    float* o_cs = o_hs + (size_t)2 * DEC * NH * DK * DV;
    float* o_ss = o_cs + (size_t)2 * DEC * 30 * CW;
    float* ws = (float*)d_ws;
    float* R1 = ws;
    float* A2 = R1 + (size_t)MT * EIN;
    float* lbs = A2 + (size_t)MT * D;

    hipMemcpyAsync(X, x_prompt, (size_t)MP * D * 4, hipMemcpyDeviceToDevice, stream);
    hipMemcpyAsync(X + (size_t)MP * D, x_sample, (size_t)DEC * D * 4, hipMemcpyDeviceToDevice, stream);
    k_lbs<<<2, 256, 0, stream>>>(lb_logits, lbs);
    for (int l = 0; l < 4; ++l) {
        const int e = l >> 1;
        if ((l & 1) == 0) {
            sgemm128<0><<<dim3(EIN / 128, MT / 128), 256, 0, stream>>>(X, D, w_in_even + (size_t)e * D * EIN, EIN, R1, EIN, D);
            k_hgrn_seq<<<NB * NH * 8, 256, 0, stream>>>(R1, 0, SEQ, nullptr, lbs + e * HW, A2, o_hp + (size_t)e * NB * NH * DK * DV);
            k_hgrn_post<<<MP, 512, 0, stream>>>(R1, 0, gnorm_w + e * DV, A2);
            k_conf<<<MP, 512, 0, stream>>>(R1, 0, SEQ, nullptr, dw_w + (size_t)e * CK * CW, dw_b + e * CW, cln_w + e * CW, cln_b + e * CW, A2, o_cp + (size_t)e * NB * 30 * CW);
            k_hgrn_seq<<<DEC * NH * 8, 256, 0, stream>>>(R1, MP, 1, state_hgrn + (size_t)e * DEC * NH * DK * DV, lbs + e * HW, A2, o_hs + (size_t)e * DEC * NH * DK * DV);
            k_hgrn_post<<<DEC, 512, 0, stream>>>(R1, MP, gnorm_w + e * DV, A2);
            k_conf<<<DEC, 512, 0, stream>>>(R1, MP, 1, state_conf + (size_t)e * DEC * 30 * CW, dw_w + (size_t)e * CK * CW, dw_b + e * CW, cln_w + e * CW, cln_b + e * CW, A2, o_cs + (size_t)e * DEC * 30 * CW);
            sgemm128<0><<<dim3(D / 128, MT / 128), 256, 0, stream>>>(A2, D, w_out_even + (size_t)e * D * D, D, R1, D, D);
        } else {
            sgemm128<0><<<dim3(EIN / 128, MT / 128), 256, 0, stream>>>(X, D, sc_w_in + (size_t)e * D * EIN, EIN, R1, EIN, D);
            k_sconv<<<MP, 1024, 0, stream>>>(R1, 0, SEQ, nullptr, sc_conv_w + (size_t)e * 3 * D, A2, o_sp + (size_t)e * NB * 2 * D);
            k_sconv<<<DEC, 1024, 0, stream>>>(R1, MP, 1, state_sconv + (size_t)e * DEC * 2 * D, sc_conv_w + (size_t)e * 3 * D, A2, o_ss + (size_t)e * DEC * 2 * D);
            sgemm128<0><<<dim3(D / 128, MT / 128), 256, 0, stream>>>(A2, D, sc_w_out + (size_t)e * D * D, D, R1, D, D);
        }
        k_ln_res<<<MT, 256, 0, stream>>>(X, R1, ln_mix_w + l * D, ln_mix_b + l * D);
        sgemm128<0><<<dim3(DFF / 128, MT / 128), 256, 0, stream>>>(X, D, ffn_w1 + (size_t)l * D * DFF, DFF, R1, DFF, D);
        sgemm128<1><<<dim3(DFF / 128, MT / 128), 256, 0, stream>>>(X, D, ffn_w3 + (size_t)l * D * DFF, DFF, R1, DFF, D);
        sgemm128<0><<<dim3(D / 128, MT / 128), 256, 0, stream>>>(R1, DFF, ffn_w2 + (size_t)l * DFF * D, D, A2, D, DFF);
        k_ln_res<<<MT, 256, 0, stream>>>(X, A2, ln_ffn_w + l * D, ln_ffn_b + l * D);
    }
}
```

```cpp
#include <hip/hip_runtime.h>
#include <cstdio>
#include <cstdint>
namespace pg8 {
#define PG8_LAS __attribute__((address_space(3)))
typedef unsigned short bf16_t;
typedef short bf16x8 __attribute__((ext_vector_type(8)));
typedef float f32x4 __attribute__((ext_vector_type(4)));
typedef unsigned u32x4 __attribute__((ext_vector_type(4)));
constexpr int BM = 256, BK = 64, HALF = 128, HTB = HALF * BK * 2  , STAGE_BYTES = 8 * HTB, NXCD = 8, WGM = 8;

__host__ __device__ __forceinline__ int lds_byte(int r, int c) { const int st = (r >> 4) * 2 + (c >> 5), rr = r & 15, cc = c & 31, ob = rr * 64 + cc * 2; return st * 1024 + (ob ^ (((ob >> 9) & 1) << 5)); }
__host__ __device__ __forceinline__ void stage_rc(int b, int& R, int& C) { const int st = b / 1024, sb = b % 1024, swz = sb ^ (((sb >> 9) & 1) << 5); R = (st >> 1) * 16 + swz / 64; C = (st & 1) * 32 + (swz % 64) / 2; }
__host__ __device__ __forceinline__ int perm32(int rho) { const int n = rho >> 4, i = rho & 15; return 8 * (i >> 2) + 4 * n + (i & 3); }

struct Unit { int pm, pn; };
struct Gemm { const bf16_t* A; const bf16_t* Bt; int M, N, K; };

struct StaticOrder {
    int nM, nN, nwg, G, c;
    __host__ __device__ void init(int M, int N, int G_, int c_) { nM = M / BM; nN = N / BM; nwg = nM * nN; G = G_; c = c_; }
    __host__ __device__ bool next(int i, Unit& u) const {
        const long L = (long)i * G + c; if (L >= nwg) return false;
        int wgid = (int)L; { const int q = nwg / NXCD, r = nwg % NXCD, xcd = wgid % NXCD, off = wgid / NXCD; wgid = (xcd < r ? xcd * (q + 1) : r * (q + 1) + (xcd - r) * q) + off; }
        const int nig = WGM * nN, gid = wgid / nig, fm = gid * WGM, gsz = (nM - fm) < WGM ? (nM - fm) : WGM;
        u.pm = fm + ((wgid % nig) % gsz); u.pn = (wgid % nig) / gsz; return true;
    }
    __device__ __forceinline__ void a_ready(const Unit&) const {}
    __device__ __forceinline__ void done(const Unit&) const {}
};

__device__ __forceinline__ unsigned cvt_pk_bf16(float lo, float hi) { unsigned r; asm volatile("v_cvt_pk_bf16_f32 %0, %1, %2" : "=v"(r) : "v"(lo), "v"(hi)); return r; }
typedef float f32x2 __attribute__((ext_vector_type(2)));
#define EPI_RETIRE() __builtin_amdgcn_s_waitcnt(0x0F70)
constexpr int MP_ = 16384, NSMP_ = 128;
constexpr float LN_EPS_ = 1e-5f, ALPHA_ = 1.6817928305074292f;
__device__ __forceinline__ float bf_lo(unsigned w) { return __uint_as_float(w << 16); }
__device__ __forceinline__ float bf_hi(unsigned w) { return __uint_as_float(w & 0xffff0000u); }
__device__ __forceinline__ float fsig(float x) { return __builtin_amdgcn_rcpf(1.f + __expf(-x)); }
__device__ __forceinline__ float fsilu(float x) { return x * fsig(x); }
struct LnIn { const float* stats; const float* c1; const float* c2; };
__device__ __forceinline__ void ln_row(const float* stats, int row, float& rA, float& rB) {
    const f32x2 s = *(const f32x2*)(stats + 2 * (size_t)row);
    const float mu = s.x * (1.f / 1024.f), var = fmaxf(s.y * (1.f / 1024.f) - mu * mu, 0.f);
    rA = __builtin_amdgcn_rsqf(var + LN_EPS_); rB = -rA * mu;
}
__device__ __forceinline__ u32x4 pack8(const f32x4& v0, const f32x4& v1) { u32x4 w; w.x = cvt_pk_bf16(v0[0], v0[1]); w.y = cvt_pk_bf16(v0[2], v0[3]); w.z = cvt_pk_bf16(v1[0], v1[1]); w.w = cvt_pk_bf16(v1[2], v1[3]); return w; }

struct EpiEvenIn {
    static constexpr bool PERM = true, AFTER_DRAIN = false;
    LnIn ln; bf16_t* PB; const float* lb; float* newc_p; float* newc_s;
    __device__ __forceinline__ void operator()(const f32x4 (&acc)[2][2][4][2], const Unit& u, int wr, int wc, int fr, int fq) const {
        const int pn = u.pn, row0 = u.pm * BM + wr * 64 + fr, gcol0 = pn * BM + wc * 32 + 8 * fq;
        f32x4 k1[2][2], k2[2][2];
#pragma unroll
        for (int bj = 0; bj < 2; ++bj)
#pragma unroll
            for (int n = 0; n < 2; ++n) { k1[bj][n] = *(const f32x4*)(ln.c1 + gcol0 + bj * HALF + 4 * n); k2[bj][n] = *(const f32x4*)(ln.c2 + gcol0 + bj * HALF + 4 * n); }
        if (pn < 8) {
            const int type = pn >> 1;
            f32x4 lbv[2][2];
#pragma unroll
            for (int bj = 0; bj < 2; ++bj)
#pragma unroll
                for (int n = 0; n < 2; ++n) lbv[bj][n] = (type == 1) ? *(const f32x4*)(lb + (gcol0 - 512) + bj * HALF + 4 * n) : (f32x4){0.f, 0.f, 0.f, 0.f};
#pragma unroll
            for (int ai = 0; ai < 2; ++ai)
#pragma unroll
                for (int m = 0; m < 4; ++m) { const int row = row0 + ai * HALF + m * 16; float rA, rB; ln_row(ln.stats, row, rA, rB);
                    bf16_t* rowp = PB + (size_t)row * 2560 + gcol0;
#pragma unroll
                    for (int bj = 0; bj < 2; ++bj) { f32x4 v[2];
#pragma unroll
                        for (int n = 0; n < 2; ++n) { v[n] = acc[ai][bj][m][n] * rA + k1[bj][n] * rB + k2[bj][n];
#pragma unroll
                            for (int j = 0; j < 4; ++j) { const float x = v[n][j]; float y;
                                if (type == 0) y = fsilu(x) * 0.08838834764831845f;
                                else if (type == 1) { const float l = lbv[bj][n][j]; y = fmaxf(__logf(l + (1.f - l) * fsig(x)), -60.f); }
                                else if (type == 2) y = x;
                                else y = fsilu(x);
                                v[n][j] = y; } }
                        *(u32x4*)(rowp + bj * HALF) = pack8(v[0], v[1]); } }
        } else {
            const int oc = (pn - 8) * 128 + wc * 32 + 8 * fq;
#pragma unroll
            for (int ai = 0; ai < 2; ++ai)
#pragma unroll
                for (int m = 0; m < 4; ++m) { const int row = row0 + ai * HALF + m * 16; float rA, rB; ln_row(ln.stats, row, rA, rB);
                    f32x4 v[2];
#pragma unroll
                    for (int n = 0; n < 2; ++n) { const f32x4 a = acc[ai][0][m][n] * rA + k1[0][n] * rB + k2[0][n], g = acc[ai][1][m][n] * rA + k1[1][n] * rB + k2[1][n];
#pragma unroll
                        for (int j = 0; j < 4; ++j) v[n][j] = a[j] * fsig(g[j]); }
                    *(u32x4*)(PB + (size_t)row * 2560 + 2048 + oc) = pack8(v[0], v[1]);
                    if (row < MP_) { const int t = row & 2047; if (t >= 2018) { float* p = newc_p + ((size_t)(row >> 11) * 30 + (t - 2018)) * 512 + oc; *(f32x4*)p = v[0]; *(f32x4*)(p + 4) = v[1]; } }
                    else if (row < MP_ + NSMP_) { float* p = newc_s + ((size_t)(row - MP_) * 30 + 29) * 512 + oc; *(f32x4*)p = v[0]; *(f32x4*)(p + 4) = v[1]; } }
        }
        EPI_RETIRE();
    }
};
struct EpiOddIn {
    static constexpr bool PERM = true, AFTER_DRAIN = false;
    LnIn ln; bf16_t* BGZ; float* news_p; float* news_s;
    __device__ __forceinline__ void operator()(const f32x4 (&acc)[2][2][4][2], const Unit& u, int wr, int wc, int fr, int fq) const {
        const int pn = u.pn, row0 = u.pm * BM + wr * 64 + fr, gcol0 = pn * BM + wc * 32 + 8 * fq;
        f32x4 k1[2][2], k2[2][2];
#pragma unroll
        for (int bj = 0; bj < 2; ++bj)
#pragma unroll
            for (int n = 0; n < 2; ++n) { k1[bj][n] = *(const f32x4*)(ln.c1 + gcol0 + bj * HALF + 4 * n); k2[bj][n] = *(const f32x4*)(ln.c2 + gcol0 + bj * HALF + 4 * n); }
        if (pn < 4) {
#pragma unroll
            for (int ai = 0; ai < 2; ++ai)
#pragma unroll
                for (int m = 0; m < 4; ++m) { const int row = row0 + ai * HALF + m * 16; float rA, rB; ln_row(ln.stats, row, rA, rB);
                    bf16_t* rowp = BGZ + (size_t)row * 2048 + gcol0;
#pragma unroll
                    for (int bj = 0; bj < 2; ++bj) { const f32x4 v0 = acc[ai][bj][m][0] * rA + k1[bj][0] * rB + k2[bj][0], v1 = acc[ai][bj][m][1] * rA + k1[bj][1] * rB + k2[bj][1];
                        *(u32x4*)(rowp + bj * HALF) = pack8(v0, v1); } }
        } else {
            const int oc = (pn - 4) * 128 + wc * 32 + 8 * fq;
#pragma unroll
            for (int ai = 0; ai < 2; ++ai)
#pragma unroll
                for (int m = 0; m < 4; ++m) { const int row = row0 + ai * HALF + m * 16; float rA, rB; ln_row(ln.stats, row, rA, rB);
                    f32x4 v[2];
#pragma unroll
                    for (int n = 0; n < 2; ++n) { const f32x4 a = acc[ai][0][m][n] * rA + k1[0][n] * rB + k2[0][n], g = acc[ai][1][m][n] * rA + k1[1][n] * rB + k2[1][n]; v[n] = a * g; }
                    *(u32x4*)(BGZ + (size_t)row * 2048 + 1024 + oc) = pack8(v[0], v[1]);
                    if (row < MP_) { const int t = row & 2047; if (t >= 2046) { float* p = news_p + ((size_t)(row >> 11) * 2 + (t - 2046)) * 1024 + oc; *(f32x4*)p = v[0]; *(f32x4*)(p + 4) = v[1]; } }
                    else if (row < MP_ + NSMP_) { float* p = news_s + ((size_t)(row - MP_) * 2 + 1) * 1024 + oc; *(f32x4*)p = v[0]; *(f32x4*)(p + 4) = v[1]; } }
        }
        EPI_RETIRE();
    }
};
struct EpiUp {
    static constexpr bool PERM = true, AFTER_DRAIN = false;
    LnIn ln; bf16_t* H;
    __device__ __forceinline__ void operator()(const f32x4 (&acc)[2][2][4][2], const Unit& u, int wr, int wc, int fr, int fq) const {
        const int pn = u.pn, row0 = u.pm * BM + wr * 64 + fr, gcol0 = pn * BM + wc * 32 + 8 * fq, oc = pn * 128 + wc * 32 + 8 * fq;
        f32x4 k1[2][2], k2[2][2];
#pragma unroll
        for (int bj = 0; bj < 2; ++bj)
#pragma unroll
            for (int n = 0; n < 2; ++n) { k1[bj][n] = *(const f32x4*)(ln.c1 + gcol0 + bj * HALF + 4 * n); k2[bj][n] = *(const f32x4*)(ln.c2 + gcol0 + bj * HALF + 4 * n); }
#pragma unroll
        for (int ai = 0; ai < 2; ++ai)
#pragma unroll
            for (int m = 0; m < 4; ++m) { const int row = row0 + ai * HALF + m * 16; float rA, rB; ln_row(ln.stats, row, rA, rB);
                f32x4 v[2];
#pragma unroll
                for (int n = 0; n < 2; ++n) { const f32x4 a = acc[ai][0][m][n] * rA + k1[0][n] * rB + k2[0][n], g = acc[ai][1][m][n] * rA + k1[1][n] * rB + k2[1][n];
#pragma unroll
                    for (int j = 0; j < 4; ++j) v[n][j] = fsilu(a[j]) * g[j]; }
                *(u32x4*)(H + (size_t)row * 2816 + oc) = pack8(v[0], v[1]); }
        EPI_RETIRE();
    }
};
template <bool F32OUT> struct EpiRes {
    static constexpr bool PERM = true, AFTER_DRAIN = false;
    const bf16_t* Zres; const float* stats_res; const float* w_res; const float* b_res; bf16_t* Zout; float* Fout; float* stats_out;
    __device__ __forceinline__ void operator()(const f32x4 (&acc)[2][2][4][2], const Unit& u, int wr, int wc, int fr, int fq) const {
        const int row0 = u.pm * BM + wr * 64 + fr, gcol0 = u.pn * BM + wc * 32 + 8 * fq;
        f32x4 wv[2][2], bv[2][2];
#pragma unroll
        for (int bj = 0; bj < 2; ++bj)
#pragma unroll
            for (int n = 0; n < 2; ++n) { wv[bj][n] = *(const f32x4*)(w_res + gcol0 + bj * HALF + 4 * n); bv[bj][n] = *(const f32x4*)(b_res + gcol0 + bj * HALF + 4 * n); }
#pragma unroll
        for (int ai = 0; ai < 2; ++ai)
#pragma unroll
            for (int m = 0; m < 4; ++m) { const int row = row0 + ai * HALF + m * 16; float rA, rB; ln_row(stats_res, row, rA, rB);
                float s = 0.f, q = 0.f;
#pragma unroll
                for (int bj = 0; bj < 2; ++bj) { const u32x4 zr = *(const u32x4*)(Zres + (size_t)row * 1024 + gcol0 + bj * HALF);
                    f32x4 x0 = {bf_lo(zr.x), bf_hi(zr.x), bf_lo(zr.y), bf_hi(zr.y)}, x1 = {bf_lo(zr.z), bf_hi(zr.z), bf_lo(zr.w), bf_hi(zr.w)};
                    f32x4 z0 = ((x0 * rA + rB) * wv[bj][0] + bv[bj][0]) * ALPHA_ + acc[ai][bj][m][0], z1 = ((x1 * rA + rB) * wv[bj][1] + bv[bj][1]) * ALPHA_ + acc[ai][bj][m][1];
                    if (F32OUT) { if (row < MP_ + NSMP_) { float* p = Fout + (size_t)row * 1024 + gcol0 + bj * HALF; *(f32x4*)p = z0; *(f32x4*)(p + 4) = z1; } }
                    else { const u32x4 w = pack8(z0, z1); *(u32x4*)(Zout + (size_t)row * 1024 + gcol0 + bj * HALF) = w;
                        z0 = (f32x4){bf_lo(w.x), bf_hi(w.x), bf_lo(w.y), bf_hi(w.y)}; z1 = (f32x4){bf_lo(w.z), bf_hi(w.z), bf_lo(w.w), bf_hi(w.w)}; }
                    s += (z0[0] + z0[1]) + (z0[2] + z0[3]) + (z1[0] + z1[1]) + (z1[2] + z1[3]);
                    q += (z0[0] * z0[0] + z0[1] * z0[1]) + (z0[2] * z0[2] + z0[3] * z0[3]) + (z1[0] * z1[0] + z1[1] * z1[1]) + (z1[2] * z1[2] + z1[3] * z1[3]); }
                s += __shfl_xor(s, 16); s += __shfl_xor(s, 32); q += __shfl_xor(q, 16); q += __shfl_xor(q, 32);
                if (fq == 0) { atomicAdd(stats_out + 2 * (size_t)row, s); atomicAdd(stats_out + 2 * (size_t)row + 1, q); } }
        EPI_RETIRE();
    }
};

__device__ __forceinline__ void glds16_asm(const void* gsrc, unsigned lds_dst) { unsigned keep;
    asm volatile("s_mov_b32 %0, m0\n\ts_mov_b32 m0, %2\n\ts_nop 0\n\tglobal_load_lds_dwordx4 %1, off\n\ts_mov_b32 m0, %0" : "=&s"(keep) : "v"(gsrc), "s"(lds_dst) : "memory"); }
template <class Epi, class Sched, bool ALIGN_EPI = false, bool SP2 = false>
__device__ __forceinline__ void gemm_phase(PG8_LAS unsigned char* lds, const Gemm g, const Sched& S, const Epi& E) {
    int tid_ = threadIdx.x; asm volatile("" : "+v"(tid_));
    const int tid = tid_, wid = __builtin_amdgcn_readfirstlane(tid >> 6), lane = tid & 63, wr = wid >> 2, wc = wid & 3, fr = lane & 15, fq = lane >> 4;
    const int K = g.K, nt = K / BK;
    unsigned voffA[2], voffB[2];
#pragma unroll
    for (int i = 0; i < 2; ++i) { int R, C; stage_rc(tid * 16 + i * 8192, R, C); const int Rb = Epi::PERM ? ((R & ~31) + perm32(R & 31)) : R;
        voffA[i] = (unsigned)(R * K + C) * 2u; voffB[i] = (unsigned)(Rb * K + C) * 2u; }
    const size_t kstep = (size_t)(BK * 2);
    const size_t hstep = (size_t)HALF * K * 2;
    const size_t tstep = 2 * hstep;
    const unsigned ldsw = (unsigned)wid * 1024u;
    const unsigned ldsb = (unsigned)__builtin_amdgcn_readfirstlane((int)((unsigned)(size_t)lds + ldsw));
    const int aoff = lds_byte(wr * 64 + fr, fq * 8), boff = lds_byte(wc * 32 + fr, fq * 8);
#define PG8_SA(b, h) (((b) * 2 + (h)) * HTB)
#define PG8_SB(b, h) ((4 + (b) * 2 + (h)) * HTB)
#define PG8_STAGE(bufoff, gbase, voff) do { _Pragma("unroll") for (int _i = 0; _i < 2; ++_i) \
        glds16_asm((const char*)(gbase) + (voff)[_i], ldsb + (unsigned)((bufoff) + _i * 8192)); } while (0)
#define PG8_LDA(dst, b, h) do { _Pragma("unroll") for (int m = 0; m < 4; ++m) _Pragma("unroll") for (int k = 0; k < 2; ++k) dst[m][k] = *(const PG8_LAS bf16x8*)(lds + PG8_SA(b, h) + aoff + m * 2048 + k * 1024); } while (0)
#define PG8_LDB(dst, b, h) do { _Pragma("unroll") for (int n = 0; n < 2; ++n) _Pragma("unroll") for (int k = 0; k < 2; ++k) dst[n][k] = *(const PG8_LAS bf16x8*)(lds + PG8_SB(b, h) + boff + n * 2048 + k * 1024); } while (0)
#define PG8_MMA(ai, bj, At, Bt) do { __builtin_amdgcn_s_setprio(1); _Pragma("unroll") for (int m = 0; m < 4; ++m) _Pragma("unroll") for (int n = 0; n < 2; ++n) _Pragma("unroll") for (int k = 0; k < 2; ++k) \
        acc[ai][bj][m][n] = __builtin_amdgcn_mfma_f32_16x16x32_bf16(Bt[n][k], At[m][k], acc[ai][bj][m][n], 0, 0, 0); __builtin_amdgcn_s_setprio(0); } while (0)
#define PG8_WAIT_V(n) asm volatile("s_waitcnt vmcnt(" #n ")" ::: "memory")
#define PG8_WAIT_L(n) asm volatile("s_waitcnt lgkmcnt(" #n ")" ::: "memory")
#define PG8_BAR __builtin_amdgcn_s_barrier()
#define PG8_SCHED __builtin_amdgcn_sched_barrier(0)
    Unit cur, nxt; int ui = 0;
    if (!S.next(0, cur)) return;
    f32x4 acc[2][2][4][2];
#pragma unroll
    for (int a = 0; a < 2; ++a)
#pragma unroll
        for (int b = 0; b < 2; ++b)
#pragma unroll
            for (int m = 0; m < 4; ++m)
#pragma unroll
                for (int n = 0; n < 2; ++n) acc[a][b][m][n] = (f32x4){0.f, 0.f, 0.f, 0.f};
    bf16x8 At[4][2], B0[2][2], B1[2][2];
    const char* cA = (const char*)g.A + (size_t)cur.pm * tstep; const char* cB = (const char*)g.Bt + (size_t)cur.pn * tstep;
    S.a_ready(cur);
    if constexpr (SP2) {
        PG8_STAGE(PG8_SB(0, 0), cB, voffB); PG8_STAGE(PG8_SB(0, 1), cB + hstep, voffB); PG8_STAGE(PG8_SA(0, 0), cA, voffA); PG8_STAGE(PG8_SA(0, 1), cA + hstep, voffA);
        if (wr == 1) PG8_BAR;
        PG8_WAIT_V(2); PG8_BAR;
        PG8_STAGE(PG8_SB(1, 0), cB + kstep, voffB); PG8_STAGE(PG8_SA(1, 0), cA + kstep, voffA); PG8_STAGE(PG8_SB(1, 1), cB + hstep + kstep, voffB);
        PG8_WAIT_V(6); PG8_BAR;
    } else {
        PG8_STAGE(PG8_SB(0, 0), cB, voffB); PG8_STAGE(PG8_SA(0, 0), cA, voffA); PG8_STAGE(PG8_SB(0, 1), cB + hstep, voffB); PG8_STAGE(PG8_SA(0, 1), cA + hstep, voffA);
        if (wr == 1) PG8_BAR;
        PG8_WAIT_V(4); PG8_BAR;
        PG8_STAGE(PG8_SB(1, 0), cB + kstep, voffB); PG8_STAGE(PG8_SA(1, 0), cA + kstep, voffA); PG8_STAGE(PG8_SB(1, 1), cB + hstep + kstep, voffB);
        PG8_WAIT_V(6); PG8_BAR;
    }
    for (;;) {
        const bool has_next = S.next(ui + 1, nxt);
        const char* nA = has_next ? (const char*)g.A + (size_t)nxt.pm * tstep : cA; const char* nB = has_next ? (const char*)g.Bt + (size_t)nxt.pn * tstep : cB;
        for (int t = 0; t < nt; t += 2) {
            const bool last = (t == nt - 2);
            const char* a1 = cA + (size_t)(t + 1) * kstep;
            const char* a2 = last ? nA : cA + (size_t)(t + 2) * kstep; const char* b2 = last ? nB : cB + (size_t)(t + 2) * kstep;
            const char* a3 = a2 + kstep; const char* b3 = b2 + kstep;
            if (last && has_next) S.a_ready(nxt);
            if constexpr (SP2) {
            PG8_LDB(B0, 0, 0); PG8_LDB(B1, 0, 1); PG8_SCHED; PG8_LDA(At, 0, 0); PG8_STAGE(PG8_SA(1, 1), a1 + hstep, voffA);
            PG8_WAIT_V(8); PG8_WAIT_L(0); PG8_BAR; PG8_MMA(0, 0, At, B0); PG8_MMA(0, 1, At, B1); PG8_BAR; PG8_SCHED;
            PG8_LDA(At, 0, 1); PG8_STAGE(PG8_SB(0, 0), b2, voffB); PG8_STAGE(PG8_SB(0, 1), b2 + hstep, voffB); PG8_STAGE(PG8_SA(0, 0), a2, voffA);
            PG8_WAIT_V(8); PG8_WAIT_L(0); PG8_BAR; PG8_MMA(1, 0, At, B0); PG8_MMA(1, 1, At, B1); PG8_BAR; PG8_SCHED;
            PG8_LDB(B0, 1, 0); PG8_LDB(B1, 1, 1); PG8_SCHED; PG8_LDA(At, 1, 0); PG8_STAGE(PG8_SA(0, 1), a2 + hstep, voffA);
            PG8_WAIT_V(8); PG8_WAIT_L(0); PG8_BAR; PG8_MMA(0, 0, At, B0); PG8_MMA(0, 1, At, B1); PG8_BAR; PG8_SCHED;
            PG8_LDA(At, 1, 1); PG8_STAGE(PG8_SB(1, 0), b3, voffB); PG8_STAGE(PG8_SB(1, 1), b3 + hstep, voffB); PG8_STAGE(PG8_SA(1, 0), a3, voffA);
            PG8_WAIT_V(8); PG8_WAIT_L(0); PG8_BAR; PG8_MMA(1, 0, At, B0); PG8_MMA(1, 1, At, B1); PG8_BAR; PG8_SCHED;
            } else {
            PG8_LDB(B0, 0, 0); PG8_SCHED; PG8_LDA(At, 0, 0); PG8_STAGE(PG8_SA(1, 1), a1 + hstep, voffA);
            PG8_WAIT_L(8); PG8_BAR; PG8_WAIT_L(0); PG8_MMA(0, 0, At, B0); PG8_BAR; PG8_SCHED;
            PG8_LDB(B1, 0, 1); PG8_STAGE(PG8_SB(0, 0), b2, voffB);
            PG8_BAR; PG8_WAIT_L(0); PG8_MMA(0, 1, At, B1); PG8_BAR;
            PG8_LDA(At, 0, 1); PG8_STAGE(PG8_SA(0, 0), a2, voffA);
            PG8_BAR; PG8_WAIT_L(0); PG8_MMA(1, 0, At, B0); PG8_BAR; PG8_SCHED;
            PG8_STAGE(PG8_SB(0, 1), b2 + hstep, voffB);
            PG8_WAIT_V(6); PG8_BAR; PG8_MMA(1, 1, At, B1); PG8_BAR;
            PG8_LDB(B0, 1, 0); PG8_SCHED; PG8_LDA(At, 1, 0); PG8_STAGE(PG8_SA(0, 1), a2 + hstep, voffA);
            PG8_WAIT_L(8); PG8_BAR; PG8_WAIT_L(0); PG8_MMA(0, 0, At, B0); PG8_BAR; PG8_SCHED;
            PG8_LDB(B1, 1, 1); PG8_STAGE(PG8_SB(1, 0), b3, voffB);
            PG8_BAR; PG8_WAIT_L(0); PG8_MMA(0, 1, At, B1); PG8_BAR;
            PG8_LDA(At, 1, 1); PG8_STAGE(PG8_SA(1, 0), a3, voffA);
            PG8_BAR; PG8_WAIT_L(0); PG8_MMA(1, 0, At, B0); PG8_BAR; PG8_SCHED;
            PG8_STAGE(PG8_SB(1, 1), b3 + hstep, voffB);
            PG8_WAIT_V(6); PG8_BAR; PG8_MMA(1, 1, At, B1); PG8_BAR;
            }
        }
        if constexpr (ALIGN_EPI) { if (wr == 0) PG8_BAR; }
        if constexpr (!Epi::AFTER_DRAIN) { E(acc, cur, wr, wc, fr, fq); S.done(cur); }
        if (!has_next) break;
#pragma unroll
        for (int a = 0; a < 2; ++a)
#pragma unroll
            for (int b = 0; b < 2; ++b)
#pragma unroll
                for (int m = 0; m < 4; ++m)
#pragma unroll
                    for (int n = 0; n < 2; ++n) acc[a][b][m][n] = (f32x4){0.f, 0.f, 0.f, 0.f};
        cur = nxt; cA = nA; cB = nB; ++ui;
        if constexpr (ALIGN_EPI) { if (wr == 1) PG8_BAR; }
    }
    PG8_WAIT_V(0);
    if constexpr (!ALIGN_EPI) { if (wr == 0) PG8_BAR; }
    PG8_BAR;
    if constexpr (Epi::AFTER_DRAIN) { E.fused(acc, cur, wr, wc, fr, fq, lds, wid, lane); S.done(cur); }
#undef PG8_SA
#undef PG8_SB
#undef PG8_STAGE
#undef PG8_LDA
#undef PG8_LDB
#undef PG8_MMA
#undef PG8_WAIT_V
#undef PG8_WAIT_L
#undef PG8_BAR
#undef PG8_SCHED
}
}

constexpr int NWAVES = 8;
constexpr int D = 1024, NB = 8, SEQ = 2048, DEC = 128, MP = NB * SEQ, MT = MP + DEC, MTP = 16640  ;
constexpr int HW = 512, NH = 4, DK = 128, DV = 128, CW = 512, CK = 31, DFF = 2816, EIN = 3072, NUP = 2 * DFF;
constexpr float LN_EPS = 1e-5f, RMS_EPS = 1e-6f;
constexpr size_t MiB = 1u << 20;
constexpr size_t WS_CTL = 0, CTL_ZERO_BYTES = 5 * MiB / 2;
constexpr size_t WS_ZEROS = 512 * 1024;
constexpr size_t WS_STATS = 1 * MiB, STATS_BYTES = (size_t)MTP * 8;
constexpr size_t WS_SMALL = 3 * MiB;
constexpr size_t WS_STATS0 = WS_SMALL, WS_ONES = WS_SMALL + 256 * 1024, WS_LBS = WS_ONES + 4096, WS_CVEC = WS_SMALL + 512 * 1024;
constexpr size_t CVEC_LAYER = (size_t)(EIN + NUP) * 2;
constexpr size_t WS_W = 4 * MiB, W_LAYER = 49 * MiB / 2;
constexpr size_t W_IN = 0, W_OUT = 6 * MiB, W_13 = 8 * MiB, W_2 = 19 * MiB;
constexpr size_t WS_ZA = 102 * MiB, WS_ZB = 135 * MiB, WS_A2 = 168 * MiB, WS_PH = 201 * MiB, WS_TMP = 291 * MiB, WS_END = 324 * MiB;
static_assert(WS_STATS + 8 * STATS_BYTES <= CTL_ZERO_BYTES && WS_CVEC + 4 * CVEC_LAYER * 4 <= WS_W && WS_W + 4 * W_LAYER <= WS_ZA && WS_ZA + (size_t)MTP * D * 2 <= WS_ZB && WS_ZB + (size_t)MTP * D * 2 <= WS_A2 &&
              WS_A2 + (size_t)MTP * D * 2 <= WS_PH && WS_PH + (size_t)MTP * DFF * 2 <= WS_TMP && WS_TMP + (size_t)MTP * HW * 4 <= WS_END, "d_ws map");
constexpr int CW_TMO = 0, CW_CODE = 1, CW_BAR = 4096;
constexpr int RING_OFF = 0, RING_BYTES = 131072, LDSCTL_OFF = RING_BYTES, MISC_OFF = LDSCTL_OFF + 320, LDS_BYTES = 147456;
#define GAS __attribute__((address_space(1)))
#define LAS __attribute__((address_space(3)))
typedef unsigned short bf16;
typedef unsigned v4u __attribute__((ext_vector_type(4)));
typedef float f32x4 __attribute__((ext_vector_type(4)));
typedef GAS unsigned gu32;
#define RLX_AGENT __ATOMIC_RELAXED, __HIP_MEMORY_SCOPE_AGENT
#define LDS_WAIT() asm volatile("s_waitcnt lgkmcnt(0)" ::: "memory")
#define VM_WAIT() asm volatile("s_waitcnt vmcnt(0)" ::: "memory")
__device__ __forceinline__ unsigned f2bf(float f) { unsigned u = __builtin_bit_cast(unsigned, f); return (u + 0x7fffu + ((u >> 16) & 1u)) >> 16; }
__device__ __forceinline__ unsigned pk2(float lo, float hi) { return f2bf(lo) | (f2bf(hi) << 16); }
__device__ __forceinline__ float bfr(float f) { return __uint_as_float(f2bf(f) << 16); }
__device__ __forceinline__ float b2f(bf16 b) { return __uint_as_float((unsigned)b << 16); }
#define XB_TMO      128
#define XB_XCNT(j)  (256  + 64 * (j))
#define XB_XSUB(j)  (1280 + 64 * (j))
#define XB_XGEN(j)  (2304 + 64 * (j))
#define XB_TOP      3328
#define XB_TOPGEN   3392
#define XCD_BAR_WORDS 3456
#define XB_SPIN_CAP (1u << 18)

__device__ __forceinline__ unsigned xb_ld(unsigned* p)              { return __hip_atomic_load(p, __ATOMIC_RELAXED, __HIP_MEMORY_SCOPE_AGENT); }
__device__ __forceinline__ unsigned xb_add(unsigned* p, unsigned v) { return __hip_atomic_fetch_add(p, v, __ATOMIC_RELAXED, __HIP_MEMORY_SCOPE_AGENT); }
__device__ __forceinline__ unsigned xb_xcc_id() { return (unsigned)__builtin_amdgcn_s_getreg((3 << 11) | 20) & 0xFu; }
#define XB_SPIN(cond, bar) do { unsigned _sp = 0; while (cond) { __builtin_amdgcn_s_sleep(1); \
    if ((++_sp & 255u) == 0u) { if (xb_ld(&(bar)[XB_TMO])) break; if (_sp > XB_SPIN_CAP) { atomicAdd(&(bar)[XB_TMO], 1u); break; } } } } while (0)

struct XcdBarrier {
    unsigned* bar; unsigned x;
    volatile LAS unsigned* st;
};

__device__ __forceinline__ XcdBarrier xcd_barrier_post(unsigned* bar, volatile LAS unsigned* st) {
    XcdBarrier b; b.bar = bar; b.x = xb_xcc_id(); b.st = st;
    if (threadIdx.x == 0) (void)xb_add(&bar[XB_XCNT(b.x)], 1u);
    return b;
}
__device__ __forceinline__ void xcd_barrier_complete(unsigned* bar, unsigned x, unsigned& nloc, unsigned& nx) {
    const unsigned G = gridDim.x * gridDim.y * gridDim.z;
    unsigned sum, cnt, mine, sp = 0u;
    for (;;) {
        sum = 0u; cnt = 0u; mine = 0u;
#pragma unroll
        for (unsigned j = 0; j < 16; ++j) { const unsigned c = xb_ld(&bar[XB_XCNT(j)]); sum += c; cnt += (c > 0u) ? 1u : 0u; mine = (j == x) ? c : mine; }
        if (sum == G) break;
        __builtin_amdgcn_s_sleep(1);
        if ((++sp & 255u) == 0u) { if (xb_ld(&bar[XB_TMO])) break; if (sp > XB_SPIN_CAP) { atomicAdd(&bar[XB_TMO], 1u); break; } }
    }
    nloc = mine > 0u ? mine : 1u; nx = cnt > 0u ? cnt : 1u;
}

__device__ __forceinline__ void xcd_barrier(const XcdBarrier& b) {
    asm volatile("s_waitcnt vmcnt(0)" ::: "memory");
    __syncthreads();
    if (threadIdx.x == 0) {
        unsigned* bar = b.bar;
        __builtin_amdgcn_s_waitcnt(0);
        unsigned nloc = b.st[0], nx = b.st[1];
        if (nloc == 0u) { xcd_barrier_complete(bar, b.x, nloc, nx); b.st[0] = nloc; b.st[1] = nx; }
        const unsigned old = xb_add(&bar[XB_XSUB(b.x)], 1u);
        const unsigned gen = old / nloc;
        if (old + 1u == (gen + 1u) * nloc) {
            __builtin_amdgcn_fence(__ATOMIC_RELEASE, "agent");
            asm volatile("s_waitcnt vmcnt(0)" ::: "memory");
            const unsigned og = xb_add(&bar[XB_TOP], 1u);
            const unsigned tg = og / nx;
            if (og + 1u == (tg + 1u) * nx) xb_add(&bar[XB_TOPGEN], 1u);
            else XB_SPIN(xb_ld(&bar[XB_TOPGEN]) == tg, bar);
            __builtin_amdgcn_fence(__ATOMIC_ACQUIRE, "agent");
            xb_add(&bar[XB_XGEN(b.x)], 1u);
            asm volatile("s_waitcnt vmcnt(0)" ::: "memory");
        } else {
            XB_SPIN(xb_ld(&bar[XB_XGEN(b.x)]) == gen, bar);
            __builtin_amdgcn_fence(__ATOMIC_ACQUIRE, "agent");
            asm volatile("s_waitcnt vmcnt(0)" ::: "memory");
        }
    }
    __syncthreads();
}
struct Args { const float* in[23]; float* out; unsigned char* ws; int ph_lo, ph_hi, li, pad; };
struct Frame { LAS unsigned char* lds; int tid, lane, wave, vcu, G; };

__device__ __forceinline__ void p0_transpose_item(const float* W, int K, int N, const float* g, bf16* WT, int drow0, int k0, int n0, LAS float* scr, int lane) {
#pragma unroll 8
    for (int i = 0; i < 32; ++i) { const int kk = 2 * i + (lane >> 5); const float sc = g ? g[k0 + kk] : 1.f; scr[kk * 33 + (lane & 31)] = W[(size_t)(k0 + kk) * N + n0 + (lane & 31)] * sc; }
    LDS_WAIT(); asm volatile("" ::: "memory");
    const int c = lane & 7;
#pragma unroll
    for (int j = 0; j < 4; ++j) { const int n = (lane >> 3) + 8 * j; const LAS float* s = scr + (8 * c) * 33 + n;
        v4u o; o.x = pk2(s[0 * 33], s[1 * 33]); o.y = pk2(s[2 * 33], s[3 * 33]); o.z = pk2(s[4 * 33], s[5 * 33]); o.w = pk2(s[6 * 33], s[7 * 33]);
        *(GAS v4u*)(WT + (size_t)(drow0 + n) * K + k0 + 8 * c) = o; }
    LDS_WAIT(); asm volatile("" ::: "memory");
}
__device__ __forceinline__ int in_src_col(int j, int odd) {
    const int jt = j >> 8, jo = j & 255, nplain = odd ? 4 : 8;
    if (jt < nplain) return j;
    const int i = jt - nplain, first = odd ? 1024 : 2048, second = odd ? 2048 : 2560;
    return (jo < 128) ? first + 128 * i + jo : second + 128 * i + (jo - 128);
}
__device__ __forceinline__ int in_dst_row(int n, int odd) {
    const int first = odd ? 1024 : 2048, second = odd ? 2048 : 2560;
    if (n < first) return n;
    if (n < second) { const int i = (n - first) >> 7, o = (n - first) & 127; return first + 256 * i + o; }
    const int i = (n - second) >> 7, o = (n - second) & 127; return first + 256 * i + 128 + o;
}
__device__ __forceinline__ void p0_prologue(const Frame& F, const Args& a) {
    unsigned char* ws = a.ws;
    LAS float* scr = (LAS float*)(F.lds + RING_OFF + F.wave * 16384);
    const int gw = F.vcu * NWAVES + F.wave, NGW = F.G * NWAVES;
    constexpr int I_IN = 16 * 96, I_OUT = 16 * 32, I_W1 = 16 * 88, I_W2 = 44 * 32, I_LAYER = I_IN + I_OUT + 2 * I_W1 + I_W2;
    for (int it = gw; it < 4 * I_LAYER; it += NGW) {
        const int l = it / I_LAYER, e = l >> 1, odd = l & 1; int r = it % I_LAYER;
        unsigned char* wl = ws + WS_W + (size_t)l * W_LAYER;
        if (r < I_IN) { const float* W = (odd ? a.in[13] : a.in[5]) + (size_t)e * D * EIN; const int kb = r / 96, nb = r % 96;
            p0_transpose_item(W, D, EIN, l > 0 ? a.in[21] + (size_t)(l - 1) * D : nullptr, (bf16*)(wl + W_IN), in_dst_row(32 * nb, odd), 64 * kb, 32 * nb, scr, F.lane); continue; } r -= I_IN;
        if (r < I_OUT) { const float* W = (odd ? a.in[15] : a.in[6]) + (size_t)e * D * D; const int kb = r / 32, nb = r % 32;
            p0_transpose_item(W, D, D, nullptr, (bf16*)(wl + W_OUT), 32 * nb, 64 * kb, 32 * nb, scr, F.lane); continue; } r -= I_OUT;
        if (r < 2 * I_W1) { const int second = r >= I_W1; if (second) r -= I_W1; const float* W = (second ? a.in[17] : a.in[16]) + (size_t)l * D * DFF; const int kb = r / 88, nb = r % 88, n0 = 32 * nb;
            p0_transpose_item(W, D, DFF, a.in[19] + (size_t)l * D, (bf16*)(wl + W_13), 256 * (n0 >> 7) + (second ? 128 : 0) + (n0 & 127), 64 * kb, n0, scr, F.lane); continue; } r -= 2 * I_W1;
        { const float* W = a.in[18] + (size_t)l * DFF * D; const int kb = r / 32, nb = r % 32;
            p0_transpose_item(W, DFF, D, nullptr, (bf16*)(wl + W_2), 32 * nb, 64 * kb, 32 * nb, scr, F.lane); }
    }
    constexpr int U_IN = EIN / 64, U_UP = NUP / 64, U_LAYER = U_IN + U_UP;
    for (int it = gw; it < 4 * U_LAYER; it += NGW) {
        const int l = it / U_LAYER, e = l >> 1, odd = l & 1; int r = it % U_LAYER;
        float* cv = (float*)(ws + WS_CVEC) + (size_t)l * CVEC_LAYER;
        const float* W; int N, src; const float* g; const float* be; float* c1; float* c2;
        if (r < U_IN) { const int j = 64 * r + F.lane; W = (odd ? a.in[13] : a.in[5]) + (size_t)e * D * EIN; N = EIN; src = in_src_col(j, odd);
            g = l > 0 ? a.in[21] + (size_t)(l - 1) * D : nullptr; be = l > 0 ? a.in[22] + (size_t)(l - 1) * D : nullptr; c1 = cv + j; c2 = cv + EIN + j; }
        else { const int j = 64 * (r - U_IN) + F.lane, i = j >> 8, jo = j & 255; W = (jo < 128 ? a.in[16] : a.in[17]) + (size_t)l * D * DFF; N = DFF; src = 128 * i + (jo & 127);
            g = a.in[19] + (size_t)l * D; be = a.in[20] + (size_t)l * D; c1 = cv + 2 * EIN + j; c2 = cv + 2 * EIN + NUP + j; }
        float s1 = 0.f, s2 = 0.f;
#pragma unroll 8
        for (int k = 0; k < D; ++k) { const float v = W[(size_t)k * N + src]; s1 += bfr(g ? g[k] * v : v); s2 += be ? be[k] * v : 0.f; }
        *c1 = s1; *c2 = s2;
    }
    for (int m = gw; m < MTP; m += NGW) {
        GAS unsigned long long* o8 = (GAS unsigned long long*)((bf16*)(ws + WS_ZA) + (size_t)m * D) + F.lane;
        if (m < MT) { const GAS f32x4* xr = (const GAS f32x4*)(m < MP ? a.in[0] + (size_t)m * D : a.in[1] + (size_t)(m - MP) * D) + F.lane;
#pragma unroll
            for (int j = 0; j < 4; ++j) { const f32x4 v = xr[64 * j]; o8[64 * j] = (unsigned long long)pk2(v.x, v.y) | ((unsigned long long)pk2(v.z, v.w) << 32); } }
        else {
#pragma unroll
            for (int j = 0; j < 4; ++j) o8[64 * j] = 0ull; }
    }
    const size_t gt = (size_t)gw * 64 + F.lane, NGT = (size_t)NGW * 64;
    for (size_t i = gt; i < (size_t)MTP; i += NGT) { float* s0 = (float*)(ws + WS_STATS0) + 2 * i; s0[0] = 0.f; s0[1] = 1024.f * (1.f - LN_EPS); }
    for (size_t i = gt; i < 1024; i += NGT) { ((float*)(ws + WS_ONES))[i] = 1.f;
        const int c = (int)i & 511; const float l0 = a.in[7][c], l1 = a.in[7][HW + c], mx = fmaxf(l0, l1), e0 = expf(l0 - mx), e1 = expf(l1 - mx);
        ((float*)(ws + WS_LBS))[i] = (i < 512) ? 0.f : e1 / (e0 + e1); }
    float* o_cs = a.out + (size_t)MT * D + (size_t)2 * NB * NH * DK * DV + (size_t)2 * NB * 30 * CW + (size_t)2 * NB * 2 * D + (size_t)2 * DEC * NH * DK * DV;
    float* o_ss = o_cs + (size_t)2 * DEC * 30 * CW;
    for (size_t i = gt; i < (size_t)2 * DEC * 29 * (CW / 4); i += NGT) { const size_t c4 = i % (CW / 4), r = i / (CW / 4), ii = r % 29, eb = r / 29;
        *(f32x4*)(o_cs + (eb * 30 + ii) * CW + c4 * 4) = *(const f32x4*)(a.in[3] + (eb * 30 + ii + 1) * CW + c4 * 4); }
    for (size_t i = gt; i < (size_t)2 * DEC * (D / 4); i += NGT) { const size_t c4 = i % (D / 4), eb = i / (D / 4);
        *(f32x4*)(o_ss + (eb * 2 + 0) * D + c4 * 4) = *(const f32x4*)(a.in[4] + (eb * 2 + 1) * D + c4 * 4); }
}
__device__ __forceinline__ void p_final_ln(const Frame& F, const Args& a) {
    const int gw = F.vcu * NWAVES + F.wave, NGW = F.G * NWAVES;
    const float* st = (const float*)(a.ws + WS_STATS + 7 * STATS_BYTES); const float* w = a.in[21] + 3 * D; const float* b = a.in[22] + 3 * D;
    for (int m = gw; m < MT; m += NGW) { float rA, rB; pg8::ln_row(st, m, rA, rB);
        GAS f32x4* xr = (GAS f32x4*)(a.out + (size_t)m * D) + F.lane;
#pragma unroll
        for (int j = 0; j < 4; ++j) { const f32x4 v = xr[64 * j], wv = *((const f32x4*)w + 64 * j + F.lane), bv = *((const f32x4*)b + 64 * j + F.lane); xr[64 * j] = (v * rA + rB) * wv + bv; } }
}
__device__ __forceinline__ const float* stats_ptr(const unsigned char* ws, int i) { return (const float*)(ws + (i == 0 ? WS_STATS0 : WS_STATS + (size_t)(i - 1) * STATS_BYTES)); }
__global__ void __launch_bounds__(NWAVES * 64, 2) mk_fwd(Args args) {
    extern __shared__ __attribute__((aligned(16))) unsigned char lds[];
    Frame F;
    F.lds = (LAS unsigned char*)lds;
    F.tid = threadIdx.x; F.lane = F.tid & 63; F.wave = __builtin_amdgcn_readfirstlane(F.tid >> 6);
    F.G = gridDim.x; { const int bx = blockIdx.x; F.vcu = (F.G % 8 == 0) ? (bx % 8) * (F.G / 8) + bx / 8 : bx; }
    unsigned char* ws = args.ws;
    gu32* ctl = (gu32*)(ws + WS_CTL);
    for (int u = F.tid; u < (LDS_BYTES - LDSCTL_OFF) / 4; u += NWAVES * 64) ((LAS unsigned*)(F.lds + LDSCTL_OFF))[u] = 0u;
    __syncthreads();
    const int lo = args.ph_lo, hi = args.ph_hi;
    XcdBarrier bar; bar.bar = (unsigned*)(ctl + CW_BAR) + args.li * XCD_BAR_WORDS; bar.x = 0; bar.st = nullptr;
    if (hi - lo > 1) bar = xcd_barrier_post((unsigned*)(ctl + CW_BAR) + args.li * XCD_BAR_WORDS, (volatile LAS unsigned*)(F.lds + MISC_OFF) + 8);
#define IN(k) (lo <= (k) && (k) < hi)
#define SEAM(k) do { if (IN((k) + 1)) xcd_barrier(bar); } while (0)
    bf16* Za = (bf16*)(ws + WS_ZA); bf16* Zb = (bf16*)(ws + WS_ZB); bf16* A2 = (bf16*)(ws + WS_A2); bf16* PH = (bf16*)(ws + WS_PH);
    float* out = args.out;
    float* o_hp = out + (size_t)MT * D; float* o_cp = o_hp + (size_t)2 * NB * NH * DK * DV; float* o_sp = o_cp + (size_t)2 * NB * 30 * CW;
    float* o_hs = o_sp + (size_t)2 * NB * 2 * D; float* o_cs = o_hs + (size_t)2 * DEC * NH * DK * DV; float* o_ss = o_cs + (size_t)2 * DEC * 30 * CW;

    if (IN(0)) { p0_prologue(F, args); SEAM(0); }
    for (int l = 0; l < 4; ++l) {
        const int pb = 1 + 6 * l, e = l >> 1;
        const unsigned char* wl = ws + WS_W + (size_t)l * W_LAYER;
        const float* cv = (const float*)(ws + WS_CVEC) + (size_t)l * CVEC_LAYER;
        if (IN(pb)) {
            pg8::Gemm g{Za, (const bf16*)(wl + W_IN), MTP, EIN, D}; pg8::StaticOrder S; S.init(MTP, EIN, F.G, (int)blockIdx.x);
            pg8::LnIn ln{stats_ptr(ws, 2 * l), cv, cv + EIN};
            if ((l & 1) == 0) { pg8::EpiEvenIn E{ln, PH, (const float*)(ws + WS_LBS) + e * HW, o_cp + (size_t)e * NB * 30 * CW, o_cs + (size_t)e * DEC * 30 * CW};
                pg8::gemm_phase<pg8::EpiEvenIn, pg8::StaticOrder, true, true>(F.lds + RING_OFF, g, S, E); }
            else { pg8::EpiOddIn E{ln, PH, o_sp + (size_t)e * NB * 2 * D, o_ss + (size_t)e * DEC * 2 * D};
                pg8::gemm_phase<pg8::EpiOddIn, pg8::StaticOrder, true, true>(F.lds + RING_OFF, g, S, E); }
            SEAM(pb);
        }
        if (IN(pb + 3)) {
            pg8::Gemm g{A2, (const bf16*)(wl + W_OUT), MTP, D, D}; pg8::StaticOrder S; S.init(MTP, D, F.G, (int)blockIdx.x);
            pg8::EpiRes<false> E{Za, stats_ptr(ws, 2 * l), l > 0 ? args.in[21] + (size_t)(l - 1) * D : (const float*)(ws + WS_ONES), l > 0 ? args.in[22] + (size_t)(l - 1) * D : (const float*)(ws + WS_ZEROS),
                                 Zb, nullptr, (float*)stats_ptr(ws, 2 * l + 1)};
            pg8::gemm_phase<pg8::EpiRes<false>, pg8::StaticOrder, true, true>(F.lds + RING_OFF, g, S, E);
            SEAM(pb + 3);
        }
        if (IN(pb + 4)) {
            pg8::Gemm g{Zb, (const bf16*)(wl + W_13), MTP, NUP, D}; pg8::StaticOrder S; S.init(MTP, NUP, F.G, (int)blockIdx.x);
            pg8::EpiUp E{pg8::LnIn{stats_ptr(ws, 2 * l + 1), cv + 2 * EIN, cv + 2 * EIN + NUP}, PH};
            pg8::gemm_phase<pg8::EpiUp, pg8::StaticOrder, true, true>(F.lds + RING_OFF, g, S, E);
            SEAM(pb + 4);
        }
        if (IN(pb + 5)) {
            pg8::Gemm g{PH, (const bf16*)(wl + W_2), MTP, D, DFF}; pg8::StaticOrder S; S.init(MTP, D, F.G, (int)blockIdx.x);
            if (l < 3) { pg8::EpiRes<false> E{Zb, stats_ptr(ws, 2 * l + 1), args.in[19] + (size_t)l * D, args.in[20] + (size_t)l * D, Za, nullptr, (float*)stats_ptr(ws, 2 * l + 2)};
                pg8::gemm_phase<pg8::EpiRes<false>, pg8::StaticOrder, true, true>(F.lds + RING_OFF, g, S, E); }
            else { pg8::EpiRes<true> E{Zb, stats_ptr(ws, 2 * l + 1), args.in[19] + (size_t)l * D, args.in[20] + (size_t)l * D, nullptr, out, (float*)stats_ptr(ws, 2 * l + 2)};
                pg8::gemm_phase<pg8::EpiRes<true>, pg8::StaticOrder, true, true>(F.lds + RING_OFF, g, S, E); }
            SEAM(pb + 5);
        }
    }
    if (IN(25)) p_final_ln(F, args);
#undef IN
#undef SEAM
}
__device__ __forceinline__ float sigmoidf_(float x) { return 1.f / (1.f + expf(-x)); }
__device__ __forceinline__ float siluf_(float x) { return x / (1.f + expf(-x)); }
__global__ __launch_bounds__(256) void k_hgrn_seq_b(const bf16* __restrict__ PB, int row0, int T, const float* __restrict__ S0, float* __restrict__ O32, float* __restrict__ Snew) {
    __shared__ float red[16][17];
    const int tid = threadIdx.x, v = tid & 15, kg = tid >> 4;
    const int vs = blockIdx.x & 7, h = (blockIdx.x >> 3) & 3, b = blockIdx.x >> 5;
    float S[8];
    const size_t sbase = (((size_t)b * NH + h) * DK) * DV + vs * 16 + v;
#pragma unroll
    for (int j = 0; j < 8; ++j) S[j] = S0 ? S0[sbase + (size_t)(kg * 8 + j) * DV] : 0.f;
    for (int t = 0; t < T; ++t) {
        const bf16* pr = PB + (size_t)(row0 + b * T + t) * 2560;
        const float vv = b2f(pr[1024 + h * DV + vs * 16 + v]);
        float part = 0.f;
#pragma unroll
        for (int j = 0; j < 8; ++j) { const int k = h * DK + kg * 8 + j; const float qq = b2f(pr[k]), f = expf(b2f(pr[512 + k])); S[j] = f * S[j] + (1.f - f) * vv; part += S[j] * qq; }
        red[kg][v] = part;
        __syncthreads();
        if (tid < 16) { float s = 0.f;
#pragma unroll
            for (int g = 0; g < 16; ++g) s += red[g][tid];
            O32[(size_t)(row0 + b * T + t) * HW + h * DV + vs * 16 + tid] = s; }
        __syncthreads();
    }
#pragma unroll
    for (int j = 0; j < 8; ++j) Snew[sbase + (size_t)(kg * 8 + j) * DV] = S[j];
}
__global__ __launch_bounds__(512) void k_hgrn_post_b(const bf16* __restrict__ PB, const float* __restrict__ O32, int row0, const float* __restrict__ gw, bf16* __restrict__ A2) {
    __shared__ float wsum[8];
    const int row = row0 + blockIdx.x, tid = threadIdx.x, v = tid & 127;
    const float o = O32[(size_t)row * HW + tid];
    float s = o * o;
    for (int d = 32; d >= 1; d >>= 1) s += __shfl_xor(s, d);
    if ((tid & 63) == 0) wsum[tid >> 6] = s;
    __syncthreads();
    const float tot = wsum[(tid >> 7) * 2] + wsum[(tid >> 7) * 2 + 1];
    A2[(size_t)row * D + tid] = (bf16)f2bf(o * rsqrtf(tot * (1.f / DV) + RMS_EPS) * gw[v] * b2f(PB[(size_t)row * 2560 + 1536 + tid]));
}
__global__ __launch_bounds__(512) void k_conf_b(const bf16* __restrict__ PB, int row0, int T, const float* __restrict__ cbuf, const float* __restrict__ dww, const float* __restrict__ dwb,
                                                const float* __restrict__ lnw, const float* __restrict__ lnb, bf16* __restrict__ A2) {
    __shared__ float wsum[8], wsum2[8];
    const int b = blockIdx.x / T, t = blockIdx.x % T, ch = threadIdx.x, tid = threadIdx.x;
    float acc = dwb[ch];
    for (int j = 0; j < CK; ++j) { const int i = t + j; float u;
        if (i < CK - 1) u = cbuf ? cbuf[((size_t)b * (CK - 1) + i) * CW + ch] : 0.f;
        else u = b2f(PB[(size_t)(row0 + b * T + (i - (CK - 1))) * 2560 + 2048 + ch]);
        acc += dww[j * CW + ch] * u; }
    float s = acc;
    for (int d = 32; d >= 1; d >>= 1) s += __shfl_xor(s, d);
    if ((tid & 63) == 0) wsum[tid >> 6] = s;
    __syncthreads();
    float mean = 0.f;
    for (int i = 0; i < 8; ++i) mean += wsum[i];
    mean *= (1.f / CW);
    const float dlt = acc - mean;
    float q = dlt * dlt;
    for (int d = 32; d >= 1; d >>= 1) q += __shfl_xor(q, d);
    if ((tid & 63) == 0) wsum2[tid >> 6] = q;
    __syncthreads();
    float var = 0.f;
    for (int i = 0; i < 8; ++i) var += wsum2[i];
    var *= (1.f / CW);
    A2[(size_t)(row0 + b * T + t) * D + HW + ch] = (bf16)f2bf(siluf_(dlt * rsqrtf(var + LN_EPS) * lnw[ch] + lnb[ch]));
}
__global__ __launch_bounds__(1024) void k_sconv_b(const bf16* __restrict__ BGZ, int row0, int T, const float* __restrict__ sbuf, const float* __restrict__ cw, bf16* __restrict__ A2) {
    const int b = blockIdx.x / T, t = blockIdx.x % T, ch = threadIdx.x;
    float conv = 0.f;
    for (int j = 0; j < 3; ++j) { const int i = t + j; float z;
        if (i < 2) z = sbuf ? sbuf[((size_t)b * 2 + i) * D + ch] : 0.f;
        else z = b2f(BGZ[(size_t)(row0 + b * T + (i - 2)) * 2048 + 1024 + ch]);
        conv += cw[j * D + ch] * z; }
    A2[(size_t)(row0 + b * T + t) * D + ch] = (bf16)f2bf(b2f(BGZ[(size_t)(row0 + b * T + t) * 2048 + ch]) * conv);
}

extern "C" void kernel_launch(void* const* d_in, const int* in_sizes, int n_in, void* d_out, int out_size, void* d_ws, size_t ws_size, hipStream_t stream) {
    static int grid = 0;
    if (grid == 0) {
        if (n_in != 23 || ws_size < WS_END) { fprintf(stderr, "kernel_launch: built for 23 inputs and >= %zu bytes of workspace; got n_in %d, ws %zu; nothing launched\n", (size_t)WS_END, n_in, ws_size); grid = -1; return; }
        int dev = 0, cus = 0;
        if (hipGetDevice(&dev) != hipSuccess || hipDeviceGetAttribute(&cus, hipDeviceAttributeMultiprocessorCount, dev) != hipSuccess) { grid = -1; return; }
        if (hipFuncSetAttribute((const void*)mk_fwd, hipFuncAttributeMaxDynamicSharedMemorySize, LDS_BYTES) != hipSuccess) { fprintf(stderr, "kernel_launch: hipFuncSetAttribute failed\n"); grid = -1; return; }
        grid = cus;
    }
    if (grid < 0) return;
    hipMemsetAsync((char*)d_ws + WS_CTL, 0, CTL_ZERO_BYTES, stream);
    Args a{};
    for (int i = 0; i < 23; ++i) a.in[i] = (const float*)d_in[i];
    a.out = (float*)d_out; a.ws = (unsigned char*)d_ws;
    int li = 0;
    auto run = [&](int lo, int hi) { a.ph_lo = lo; a.ph_hi = hi; a.li = li++; hipLaunchKernelGGL(mk_fwd, dim3(grid), dim3(NWAVES * 64), LDS_BYTES, stream, a); };
    unsigned char* ws = (unsigned char*)d_ws;
    const bf16* PH = (const bf16*)(ws + WS_PH); bf16* A2 = (bf16*)(ws + WS_A2); float* O32 = (float*)(ws + WS_TMP);
    float* out = (float*)d_out;
    float* o_hp = out + (size_t)MT * D; float* o_cp = o_hp + (size_t)2 * NB * NH * DK * DV; float* o_sp = o_cp + (size_t)2 * NB * 30 * CW;
    float* o_hs = o_sp + (size_t)2 * NB * 2 * D;
    run(0, 1);
    for (int l = 0; l < 4; ++l) {
        const int pb = 1 + 6 * l, e = l >> 1;
        run(pb, pb + 1);
        if ((l & 1) == 0) {
            k_hgrn_seq_b<<<NB * NH * 8, 256, 0, stream>>>(PH, 0, SEQ, nullptr, O32, o_hp + (size_t)e * NB * NH * DK * DV);
            k_hgrn_post_b<<<MP, 512, 0, stream>>>(PH, O32, 0, a.in[8] + e * DV, A2);
            k_conf_b<<<MP, 512, 0, stream>>>(PH, 0, SEQ, nullptr, a.in[9] + (size_t)e * CK * CW, a.in[10] + e * CW, a.in[11] + e * CW, a.in[12] + e * CW, A2);
            k_hgrn_seq_b<<<DEC * NH * 8, 256, 0, stream>>>(PH, MP, 1, a.in[2] + (size_t)e * DEC * NH * DK * DV, O32, o_hs + (size_t)e * DEC * NH * DK * DV);
            k_hgrn_post_b<<<DEC, 512, 0, stream>>>(PH, O32, MP, a.in[8] + e * DV, A2);
            k_conf_b<<<DEC, 512, 0, stream>>>(PH, MP, 1, a.in[3] + (size_t)e * DEC * 30 * CW, a.in[9] + (size_t)e * CK * CW, a.in[10] + e * CW, a.in[11] + e * CW, a.in[12] + e * CW, A2);
        } else {
            k_sconv_b<<<MP, 1024, 0, stream>>>(PH, 0, SEQ, nullptr, a.in[14] + (size_t)e * 3 * D, A2);
            k_sconv_b<<<DEC, 1024, 0, stream>>>(PH, MP, 1, a.in[4] + (size_t)e * DEC * 2 * D, a.in[14] + (size_t)e * 3 * D, A2);
        }
        run(pb + 3, pb + 4); run(pb + 4, pb + 5); run(pb + 5, pb + 6);
    }
    run(25, 26);
}
```

```cpp
#include <hip/hip_runtime.h>
#include <cstdio>
#include <cstdint>
__device__ __forceinline__ int lane_id_now() { int l; asm volatile("v_mbcnt_lo_u32_b32 %0, -1, 0\n\tv_mbcnt_hi_u32_b32 %0, -1, %0" : "=v"(l)); return l; }
namespace pg8 {
#define PG8_LAS __attribute__((address_space(3)))
typedef unsigned short bf16_t;
typedef short bf16x8 __attribute__((ext_vector_type(8)));
typedef float f32x4 __attribute__((ext_vector_type(4)));
typedef unsigned u32x4 __attribute__((ext_vector_type(4)));
constexpr int BM = 256, BK = 64, HALF = 128, HTB = HALF * BK * 2  , STAGE_BYTES = 8 * HTB, NXCD = 8, WGM = 8;

__host__ __device__ __forceinline__ int lds_byte(int r, int c) { const int st = (r >> 4) * 2 + (c >> 5), rr = r & 15, cc = c & 31, ob = rr * 64 + cc * 2; return st * 1024 + (ob ^ (((ob >> 9) & 1) << 5)); }
__host__ __device__ __forceinline__ void stage_rc(int b, int& R, int& C) { const int st = b / 1024, sb = b % 1024, swz = sb ^ (((sb >> 9) & 1) << 5); R = (st >> 1) * 16 + swz / 64; C = (st & 1) * 32 + (swz % 64) / 2; }
__host__ __device__ __forceinline__ int perm32(int rho) { const int n = rho >> 4, i = rho & 15; return 8 * (i >> 2) + 4 * n + (i & 3); }

struct Unit { int pm, pn; };
struct Gemm { const bf16_t* A; const bf16_t* Bt; int M, N, K; };

struct StaticOrder {
    int nM, nN, nwg, G, c;
    __host__ __device__ void init(int M, int N, int G_, int c_) { nM = M / BM; nN = N / BM; nwg = nM * nN; G = G_; c = c_; }
    __host__ __device__ bool next(int i, Unit& u) const {
        const long L = (long)i * G + c; if (L >= nwg) return false;
        int wgid = (int)L; { const int q = nwg / NXCD, r = nwg % NXCD, xcd = wgid % NXCD, off = wgid / NXCD; wgid = (xcd < r ? xcd * (q + 1) : r * (q + 1) + (xcd - r) * q) + off; }
        const int nig = WGM * nN, gid = wgid / nig, fm = gid * WGM, gsz = (nM - fm) < WGM ? (nM - fm) : WGM;
        u.pm = fm + ((wgid % nig) % gsz); u.pn = (wgid % nig) / gsz; return true;
    }
    __device__ __forceinline__ void a_ready(const Unit&) const {}
    __device__ __forceinline__ void done(const Unit&) const {}
};

__device__ __forceinline__ unsigned cvt_pk_bf16(float lo, float hi) { unsigned r; asm volatile("v_cvt_pk_bf16_f32 %0, %1, %2" : "=v"(r) : "v"(lo), "v"(hi)); return r; }
typedef float f32x2 __attribute__((ext_vector_type(2)));
#define EPI_RETIRE() __builtin_amdgcn_s_waitcnt(0x0F70)
constexpr int MP_ = 16384, NSMP_ = 128;
constexpr float LN_EPS_ = 1e-5f, ALPHA_ = 1.6817928305074292f;
__device__ __forceinline__ float bf_lo(unsigned w) { return __uint_as_float(w << 16); }
__device__ __forceinline__ float bf_hi(unsigned w) { return __uint_as_float(w & 0xffff0000u); }
__device__ __forceinline__ float fsig(float x) { return __builtin_amdgcn_rcpf(1.f + __expf(-x)); }
__device__ __forceinline__ float fsilu(float x) { return x * fsig(x); }
__device__ __forceinline__ f32x4 vsig(const f32x4& x) { const f32x4 t = x * -1.4426950408889634f; f32x4 e;
#pragma unroll
    for (int j = 0; j < 4; ++j) e[j] = __builtin_amdgcn_exp2f(t[j]);
    e = e + 1.f; f32x4 r;
#pragma unroll
    for (int j = 0; j < 4; ++j) r[j] = __builtin_amdgcn_rcpf(e[j]);
    return r; }
__device__ __forceinline__ f32x4 vsilu(const f32x4& x) { return x * vsig(x); }
__device__ __forceinline__ f32x4 vlogf_gate(const f32x4& lb, const f32x4& x) { const f32x4 y = (1.f - lb) * vsig(x) + lb; f32x4 r;
#pragma unroll
    for (int j = 0; j < 4; ++j) r[j] = fmaxf(__builtin_amdgcn_logf(y[j]) * 0.6931471805599453f, -60.f);
    return r; }
struct LnIn { const float* stats; const float* c1; const float* c2; };
__device__ __forceinline__ void ln_row(const float* stats, int row, float& rA, float& rB) {
    const f32x2 s = *(const f32x2*)(stats + 2 * (size_t)row);
    const float mu = s.x * (1.f / 1024.f), var = fmaxf(s.y * (1.f / 1024.f) - mu * mu, 0.f);
    rA = __builtin_amdgcn_rsqf(var + LN_EPS_); rB = -rA * mu;
}
constexpr int EPV_OFF = 132096, EPV_BYTES = 4096;
__device__ __forceinline__ void glds4_asm(const void* gsrc, unsigned lds_dst) { unsigned keep;
    asm volatile("s_mov_b32 %0, m0\n\ts_mov_b32 m0, %2\n\ts_nop 0\n\tglobal_load_lds_dword %1, off\n\ts_mov_b32 m0, %0" : "=&s"(keep) : "v"(gsrc), "s"(lds_dst) : "memory"); }
template <class Epi> __device__ __forceinline__ void epi_prefetch(const Epi& E, int pm, int pn, unsigned ev_wave, int tid) {
    glds4_asm(E.pf_stats() + (size_t)pm * 512 + tid, ev_wave);
    glds4_asm((tid < 256 ? E.pf_c1() : E.pf_c2() - 256) + pn * 256 + tid, ev_wave + 2048u);
}
__device__ __forceinline__ void ln_row_lds(const PG8_LAS unsigned char* ev, int rl, float& rA, float& rB) {
    const f32x2 s = *(const PG8_LAS f32x2*)(ev + rl * 8);
    const float mu = s.x * (1.f / 1024.f), var = fmaxf(s.y * (1.f / 1024.f) - mu * mu, 0.f);
    rA = __builtin_amdgcn_rsqf(var + LN_EPS_); rB = -rA * mu;
}
#define EPV_K(dst1, dst2) do { _Pragma("unroll") for (int bj = 0; bj < 2; ++bj) _Pragma("unroll") for (int n = 0; n < 2; ++n) { \
        dst1[bj][n] = *(const PG8_LAS f32x4*)(ev + 2048 + (wc * 32 + 8 * fq + bj * HALF + 4 * n) * 4); dst2[bj][n] = *(const PG8_LAS f32x4*)(ev + 3072 + (wc * 32 + 8 * fq + bj * HALF + 4 * n) * 4); } } while (0)
__device__ __forceinline__ void ln_rows8(const float* stats, int row0, float (&rA)[8], float (&rB)[8]) {
    f32x2 sv[8];
#pragma unroll
    for (int q = 0; q < 8; ++q) sv[q] = *(const f32x2*)(stats + 2 * (size_t)(row0 + (q >> 2) * HALF + (q & 3) * 16));
#pragma unroll
    for (int q = 0; q < 8; ++q) { const float mu = sv[q].x * (1.f / 1024.f), var = fmaxf(sv[q].y * (1.f / 1024.f) - mu * mu, 0.f); rA[q] = __builtin_amdgcn_rsqf(var + LN_EPS_); rB[q] = -rA[q] * mu; }
}
__device__ __forceinline__ void ln_rows4(const float* stats, int rowh, float (&rA)[4], float (&rB)[4]) {
    f32x2 sv[4];
#pragma unroll
    for (int q = 0; q < 4; ++q) sv[q] = *(const f32x2*)(stats + 2 * (size_t)(rowh + q * 16));
#pragma unroll
    for (int q = 0; q < 4; ++q) { const float mu = sv[q].x * (1.f / 1024.f), var = fmaxf(sv[q].y * (1.f / 1024.f) - mu * mu, 0.f); rA[q] = __builtin_amdgcn_rsqf(var + LN_EPS_); rB[q] = -rA[q] * mu; }
}
__device__ __forceinline__ u32x4 pack8(const f32x4& v0, const f32x4& v1) { u32x4 w; w.x = cvt_pk_bf16(v0[0], v0[1]); w.y = cvt_pk_bf16(v0[2], v0[3]); w.z = cvt_pk_bf16(v1[0], v1[1]); w.w = cvt_pk_bf16(v1[2], v1[3]); return w; }

struct EpiEvenIn {
    static constexpr bool PERM = true, AFTER_DRAIN = false;
    __device__ __forceinline__ const float* pf_stats() const { return ln.stats; } __device__ __forceinline__ const float* pf_c1() const { return ln.c1; } __device__ __forceinline__ const float* pf_c2() const { return ln.c2; }
    LnIn ln; bf16_t* PB; const float* lb; float* newc_p; float* newc_s;
    __device__ __forceinline__ void operator()(const f32x4 (&acc)[2][2][4][2], const Unit& u, int wr, int wc, int fr, int fq, int rowmask, const PG8_LAS unsigned char* ev) const {
        const int pn = u.pn, row0 = u.pm * BM + wr * 64 + fr, gcol0 = pn * BM + wc * 32 + 8 * fq;
        f32x4 k1[2][2], k2[2][2]; EPV_K(k1, k2);
        const int rl0 = wr * 64 + fr;
        if (pn < 8) {
            const int type = pn >> 1;
#define EVEN_ROWS(FN) do { _Pragma("unroll") for (int ai = 0; ai < 2; ++ai) { \
                _Pragma("unroll") for (int m = 0; m < 4; ++m) { if (!((rowmask >> (ai * 4 + m)) & 1)) continue; const int row = row0 + ai * HALF + m * 16; float rA, rB; ln_row_lds(ev, rl0 + ai * HALF + m * 16, rA, rB); \
                    bf16_t* rowp = PB + (size_t)row * 2560 + gcol0; \
                    _Pragma("unroll") for (int bj = 0; bj < 2; ++bj) { f32x4 v[2]; \
                        _Pragma("unroll") for (int n = 0; n < 2; ++n) { const f32x4 xv = acc[ai][bj][m][n] * rA + (k1[bj][n] * rB + k2[bj][n]); v[n] = FN; } \
                        *(u32x4*)(rowp + bj * HALF) = pack8(v[0], v[1]); } } } } while (0)
            if (type == 0) EVEN_ROWS(vsilu(xv) * 0.08838834764831845f);
            else if (type == 1) { f32x4 lbv[2][2];
#pragma unroll
                for (int bj = 0; bj < 2; ++bj)
#pragma unroll
                    for (int n = 0; n < 2; ++n) lbv[bj][n] = *(const f32x4*)(lb + (gcol0 - 512) + bj * HALF + 4 * n);
                EVEN_ROWS(vlogf_gate(lbv[bj][n], xv)); }
            else if (type == 2) EVEN_ROWS(xv);
            else EVEN_ROWS(vsilu(xv));
#undef EVEN_ROWS
        } else {
            const int oc = (pn - 8) * 128 + wc * 32 + 8 * fq;
#pragma unroll
            for (int ai = 0; ai < 2; ++ai) {
#pragma unroll
                for (int m = 0; m < 4; ++m) { if (!((rowmask >> (ai * 4 + m)) & 1)) continue; const int row = row0 + ai * HALF + m * 16; float rA, rB; ln_row_lds(ev, wr * 64 + fr + ai * HALF + m * 16, rA, rB);
                    f32x4 v[2];
#pragma unroll
                    for (int n = 0; n < 2; ++n) { const f32x4 a = acc[ai][0][m][n] * rA + (k1[0][n] * rB + k2[0][n]), g = acc[ai][1][m][n] * rA + (k1[1][n] * rB + k2[1][n]);
                        v[n] = a * vsig(g); }
                    *(u32x4*)(PB + (size_t)row * 2560 + 2048 + oc) = pack8(v[0], v[1]);
                    if (row < MP_) { const int t = row & 2047; if (t >= 2018) { float* p = newc_p + ((size_t)(row >> 11) * 30 + (t - 2018)) * 512 + oc; *(f32x4*)p = v[0]; *(f32x4*)(p + 4) = v[1]; } }
                    else if (row < MP_ + NSMP_) { float* p = newc_s + ((size_t)(row - MP_) * 30 + 29) * 512 + oc; *(f32x4*)p = v[0]; *(f32x4*)(p + 4) = v[1]; } } }
        }
    }
};
struct EpiOddIn {
    static constexpr bool PERM = true, AFTER_DRAIN = false;
    __device__ __forceinline__ const float* pf_stats() const { return ln.stats; } __device__ __forceinline__ const float* pf_c1() const { return ln.c1; } __device__ __forceinline__ const float* pf_c2() const { return ln.c2; }
    LnIn ln; bf16_t* BGZ; float* news_p; float* news_s;
    __device__ __forceinline__ void operator()(const f32x4 (&acc)[2][2][4][2], const Unit& u, int wr, int wc, int fr, int fq, int rowmask, const PG8_LAS unsigned char* ev) const {
        const int pn = u.pn, row0 = u.pm * BM + wr * 64 + fr, gcol0 = pn * BM + wc * 32 + 8 * fq;
        f32x4 k1[2][2], k2[2][2]; EPV_K(k1, k2);
        const int rl0 = wr * 64 + fr;
        if (pn < 4) {
#pragma unroll
            for (int ai = 0; ai < 2; ++ai) {
#pragma unroll
                for (int m = 0; m < 4; ++m) { if (!((rowmask >> (ai * 4 + m)) & 1)) continue; const int row = row0 + ai * HALF + m * 16; float rA, rB; ln_row_lds(ev, wr * 64 + fr + ai * HALF + m * 16, rA, rB);
                    bf16_t* rowp = BGZ + (size_t)row * 2048 + gcol0;
#pragma unroll
                    for (int bj = 0; bj < 2; ++bj) { const f32x4 v0 = acc[ai][bj][m][0] * rA + (k1[bj][0] * rB + k2[bj][0]), v1 = acc[ai][bj][m][1] * rA + (k1[bj][1] * rB + k2[bj][1]);
                        *(u32x4*)(rowp + bj * HALF) = pack8(v0, v1); } } }
        } else {
            const int oc = (pn - 4) * 128 + wc * 32 + 8 * fq;
#pragma unroll
            for (int ai = 0; ai < 2; ++ai) {
#pragma unroll
                for (int m = 0; m < 4; ++m) { if (!((rowmask >> (ai * 4 + m)) & 1)) continue; const int row = row0 + ai * HALF + m * 16; float rA, rB; ln_row_lds(ev, wr * 64 + fr + ai * HALF + m * 16, rA, rB);
                    f32x4 v[2];
#pragma unroll
                    for (int n = 0; n < 2; ++n) { const f32x4 a = acc[ai][0][m][n] * rA + (k1[0][n] * rB + k2[0][n]), g = acc[ai][1][m][n] * rA + (k1[1][n] * rB + k2[1][n]); v[n] = a * g; }
                    *(u32x4*)(BGZ + (size_t)row * 2048 + 1024 + oc) = pack8(v[0], v[1]);
                    if (row < MP_) { const int t = row & 2047; if (t >= 2046) { float* p = news_p + ((size_t)(row >> 11) * 2 + (t - 2046)) * 1024 + oc; *(f32x4*)p = v[0]; *(f32x4*)(p + 4) = v[1]; } }
                    else if (row < MP_ + NSMP_) { float* p = news_s + ((size_t)(row - MP_) * 2 + 1) * 1024 + oc; *(f32x4*)p = v[0]; *(f32x4*)(p + 4) = v[1]; } } }
        }
    }
};
struct EpiUp {
    static constexpr bool PERM = true, AFTER_DRAIN = false;
    __device__ __forceinline__ const float* pf_stats() const { return ln.stats; } __device__ __forceinline__ const float* pf_c1() const { return ln.c1; } __device__ __forceinline__ const float* pf_c2() const { return ln.c2; }
    LnIn ln; bf16_t* H;
    __device__ __forceinline__ void operator()(const f32x4 (&acc)[2][2][4][2], const Unit& u, int wr, int wc, int fr, int fq, int rowmask, const PG8_LAS unsigned char* ev) const {
        const int pn = u.pn, row0 = u.pm * BM + wr * 64 + fr, gcol0 = pn * BM + wc * 32 + 8 * fq, oc = pn * 128 + wc * 32 + 8 * fq;
        f32x4 k1[2][2], k2[2][2]; EPV_K(k1, k2);
        const int rl0 = wr * 64 + fr;
#pragma unroll
        for (int ai = 0; ai < 2; ++ai)
#pragma unroll
            for (int m = 0; m < 4; ++m) { if (!((rowmask >> (ai * 4 + m)) & 1)) continue; const int row = row0 + ai * HALF + m * 16; float rA, rB; ln_row_lds(ev, rl0 + ai * HALF + m * 16, rA, rB);
                f32x4 v[2];
#pragma unroll
                for (int n = 0; n < 2; ++n) { const f32x4 a = acc[ai][0][m][n] * rA + (k1[0][n] * rB + k2[0][n]), g = acc[ai][1][m][n] * rA + (k1[1][n] * rB + k2[1][n]);
                    v[n] = vsilu(a) * g; }
                *(u32x4*)(H + (size_t)row * 2816 + oc) = pack8(v[0], v[1]); }
    }
};
template <bool F32OUT> struct EpiRes {
    static constexpr bool PERM = true, AFTER_DRAIN = false;
    __device__ __forceinline__ const float* pf_stats() const { return stats_res; } __device__ __forceinline__ const float* pf_c1() const { return w_res; } __device__ __forceinline__ const float* pf_c2() const { return b_res; }
    const bf16_t* Zres; const float* stats_res; const float* w_res; const float* b_res; bf16_t* Zout; float* Fout; float* stats_out;
    __device__ __forceinline__ void operator()(const f32x4 (&acc)[2][2][4][2], const Unit& u, int wr, int wc, int fr, int fq, int rowmask, const PG8_LAS unsigned char* ev) const {
        const int row0 = u.pm * BM + wr * 64 + fr, gcol0 = u.pn * BM + wc * 32 + 8 * fq;
        const unsigned zoff0 = (unsigned)(row0 * 1024 + gcol0) * 2u;
        u32x4 zpre[2][4][2];
#pragma unroll
        for (int ai = 0; ai < 2; ++ai)
#pragma unroll
            for (int m = 0; m < 4; ++m)
#pragma unroll
                for (int bj = 0; bj < 2; ++bj) zpre[ai][m][bj] = ((rowmask >> (ai * 4 + m)) & 1) ? *(const u32x4*)((const char*)Zres + (zoff0 + (unsigned)((ai * HALF + m * 16) * 2048 + bj * HALF * 2))) : (u32x4){0u, 0u, 0u, 0u};
#pragma unroll
        for (int ai = 0; ai < 2; ++ai) {
#pragma unroll
            for (int m = 0; m < 4; ++m) { if (!((rowmask >> (ai * 4 + m)) & 1)) continue; const int row = row0 + ai * HALF + m * 16; float rA, rB; ln_row_lds(ev, wr * 64 + fr + ai * HALF + m * 16, rA, rB);
                float s = 0.f, q = 0.f;
#pragma unroll
                for (int bj = 0; bj < 2; ++bj) { const u32x4 zr = zpre[ai][m][bj];
                    f32x4 x0 = {bf_lo(zr.x), bf_hi(zr.x), bf_lo(zr.y), bf_hi(zr.y)}, x1 = {bf_lo(zr.z), bf_hi(zr.z), bf_lo(zr.w), bf_hi(zr.w)};
                    const PG8_LAS f32x4* kp = (const PG8_LAS f32x4*)(ev + 2048 + (wc * 32 + 8 * fq + bj * HALF) * 4);
                    f32x4 z0 = ((x0 * rA + rB) * kp[0] + kp[64]) * ALPHA_ + acc[ai][bj][m][0], z1 = ((x1 * rA + rB) * kp[1] + kp[65]) * ALPHA_ + acc[ai][bj][m][1];
                    if (F32OUT) { if (row < MP_ + NSMP_) { float* p = Fout + (size_t)row * 1024 + gcol0 + bj * HALF; *(f32x4*)p = z0; *(f32x4*)(p + 4) = z1; } }
                    else { const u32x4 w = pack8(z0, z1); *(u32x4*)(Zout + (size_t)row * 1024 + gcol0 + bj * HALF) = w;
                        z0 = (f32x4){bf_lo(w.x), bf_hi(w.x), bf_lo(w.y), bf_hi(w.y)}; z1 = (f32x4){bf_lo(w.z), bf_hi(w.z), bf_lo(w.w), bf_hi(w.w)}; }
                    s += (z0[0] + z0[1]) + (z0[2] + z0[3]) + (z1[0] + z1[1]) + (z1[2] + z1[3]);
                    q += (z0[0] * z0[0] + z0[1] * z0[1]) + (z0[2] * z0[2] + z0[3] * z0[3]) + (z1[0] * z1[0] + z1[1] * z1[1]) + (z1[2] * z1[2] + z1[3] * z1[3]); }
                s += __shfl_xor(s, 16); s += __shfl_xor(s, 32); q += __shfl_xor(q, 16); q += __shfl_xor(q, 32);
                if (fq == 0) { atomicAdd(stats_out + 2 * (size_t)row, s); atomicAdd(stats_out + 2 * (size_t)row + 1, q); } } }
        EPI_RETIRE();
    }
};

template <class Epi, int RT = 4>
__device__ __forceinline__ void mini_gemm(PG8_LAS unsigned char* lds, const bf16_t* A, const bf16_t* Bt, int K, const Epi& E, int mu, int wave_u) {
    int tid_ = wave_u * 64 + lane_id_now(); asm volatile("" : "+v"(tid_));
    const int tid = tid_, w = __builtin_amdgcn_readfirstlane(tid >> 6), lane = tid & 63, li = lane & 15, lq = lane >> 4;
    constexpr int RB = RT == 4 ? 1 : 2, NT = RT * 4;
    const int rsel = mu & ((1 << RB) - 1), wc = (mu >> RB) & 3, j = mu >> (RB + 2);
    const int kslice = K >> 3, nks = kslice >> 5;
    epi_prefetch(E, MP_ / BM, j, (unsigned)__builtin_amdgcn_readfirstlane((int)((unsigned)(size_t)lds + (unsigned)EPV_OFF + (unsigned)w * 256u)), tid);
    const bf16_t* ap = A + (size_t)(MP_ + 16 * RT * rsel + li) * K + w * kslice + 8 * lq;
    const bf16_t* bp = Bt + (size_t)(256 * j + 32 * wc + li) * K + w * kslice + 8 * lq;
    f32x4 acc[RT][4];
#pragma unroll
    for (int a = 0; a < RT; ++a)
#pragma unroll
        for (int b = 0; b < 4; ++b) acc[a][b] = (f32x4){0.f, 0.f, 0.f, 0.f};
#pragma unroll 1
    for (int ks0 = 0; ks0 < nks; ks0 += 4) {
        bf16x8 af[4][RT], bfr[4][4];
#pragma unroll
        for (int i = 0; i < 4; ++i) if (ks0 + i < nks) {
#pragma unroll
            for (int x = 0; x < 4; ++x) { if (x < RT) af[i][x] = *(const bf16x8*)(ap + (size_t)(16 * x) * K + 32 * (ks0 + i)); bfr[i][x] = *(const bf16x8*)(bp + (size_t)(128 * (x >> 1) + 16 * (x & 1)) * K + 32 * (ks0 + i)); } }
#pragma unroll
        for (int i = 0; i < 4; ++i) if (ks0 + i < nks) {
#pragma unroll
            for (int mt = 0; mt < RT; ++mt)
#pragma unroll
                for (int nt = 0; nt < 4; ++nt) acc[mt][nt] = __builtin_amdgcn_mfma_f32_16x16x32_bf16(bfr[i][nt], af[i][mt], acc[mt][nt], 0, 0, 0); }
    }
    PG8_LAS f32x4* PART = (PG8_LAS f32x4*)lds;
#pragma unroll
    for (int mt = 0; mt < RT; ++mt)
#pragma unroll
        for (int nt = 0; nt < 4; ++nt) PART[(w * NT + 4 * mt + nt) * 64 + lane] = acc[mt][nt];
    asm volatile("s_waitcnt vmcnt(0) lgkmcnt(0)" ::: "memory"); __builtin_amdgcn_s_barrier(); asm volatile("" ::: "memory");
    {
#pragma unroll
        for (int x = 0; x < NT / 8; ++x) { const int tl = (NT / 8) * w + x; f32x4 s0 = PART[tl * 64 + lane];
#pragma unroll
            for (int q = 1; q < 8; ++q) s0 += PART[(q * NT + tl) * 64 + lane];
            PART[tl * 64 + lane] = s0; } }
    asm volatile("s_waitcnt lgkmcnt(0)" ::: "memory"); __builtin_amdgcn_s_barrier(); asm volatile("" ::: "memory");
    if (w < RT) {
        const int fr = li, fq = lq;
        f32x4 big[2][2][4][2];
#pragma unroll
        for (int m = 0; m < 4; ++m)
#pragma unroll
            for (int bj = 0; bj < 2; ++bj)
#pragma unroll
                for (int n = 0; n < 2; ++n) { big[0][bj][m][n] = m < RT ? PART[(4 * m + 2 * bj + (fq >> 1)) * 64 + (2 * (fq & 1) + n) * 16 + fr] : (f32x4){0.f, 0.f, 0.f, 0.f}; big[1][bj][m][n] = (f32x4){0.f, 0.f, 0.f, 0.f}; }
        Unit u; u.pm = MP_ / BM; u.pn = j;
        if constexpr (RT == 4) E(big, u, rsel, wc, fr, fq, 1 << w, lds + EPV_OFF); else E(big, u, rsel >> 1, wc, fr + 32 * (rsel & 1), fq, 1 << w, lds + EPV_OFF);
    }
    asm volatile("s_waitcnt lgkmcnt(0)" ::: "memory"); __builtin_amdgcn_s_barrier(); asm volatile("" ::: "memory");
}
__device__ __forceinline__ void glds16_m(const void* gsrc, unsigned lds_dst) { unsigned keep;
    asm volatile("s_mov_b32 %0, m0\n\ts_mov_b32 m0, %2\n\ts_nop 0\n\tglobal_load_lds_dwordx4 %1, off\n\ts_mov_b32 m0, %0" : "=&s"(keep) : "v"(gsrc), "s"(lds_dst) : "memory"); }
template <class Epi>
__device__ __forceinline__ void mini_ring(PG8_LAS unsigned char* lds, const bf16_t* A, const bf16_t* Bt, int K, const Epi& E, int mu, int wave_u) {
    constexpr int NS = 8, PD = 6, SLOT = 128 * 128;
    int tid_ = wave_u * 64 + lane_id_now(); asm volatile("" : "+v"(tid_));
    const int tid = tid_, w = __builtin_amdgcn_readfirstlane(tid >> 6), lane = tid & 63, fr = lane & 15, fq = lane >> 4;
    const int rsel = mu & 1, wc = (mu >> 1) & 3, j = mu >> 3, nchunk = K >> 6;
    epi_prefetch(E, MP_ / BM, j, (unsigned)__builtin_amdgcn_readfirstlane((int)((unsigned)(size_t)lds + (unsigned)EPV_OFF + (unsigned)w * 256u)), tid);
    const char* src[2];
#pragma unroll
    for (int i = 0; i < 2; ++i) { const int P = tid + 512 * i, row = P >> 3, q = (P & 7) ^ (row & 7);
        const bf16_t* rp = row < 64 ? A + (size_t)(MP_ + 64 * rsel + row) * K : Bt + (size_t)(256 * j + 128 * ((row - 64) >> 5) + 32 * wc + perm32((row - 64) & 31)) * K;
        src[i] = (const char*)rp + 16 * q; }
    const unsigned ldw = (unsigned)__builtin_amdgcn_readfirstlane((int)((unsigned)(size_t)lds + (unsigned)w * 1024u));
#define MR_ISSUE(c) do { const unsigned sb_ = ldw + (unsigned)(((c) & (NS - 1)) * SLOT); glds16_m(src[0] + (size_t)(c) * 128, sb_); glds16_m(src[1] + (size_t)(c) * 128, sb_ + 8192u); } while (0)
#pragma unroll
    for (int c = 0; c < PD; ++c) MR_ISSUE(c);
    f32x4 acc[2][2];
#pragma unroll
    for (int b = 0; b < 2; ++b)
#pragma unroll
        for (int n = 0; n < 2; ++n) acc[b][n] = (f32x4){0.f, 0.f, 0.f, 0.f};
    const int x0 = ((fq) ^ (fr & 7)) * 16, x1 = ((4 + fq) ^ (fr & 7)) * 16;
    const int aoff = (16 * (w & 3) + fr) * 128;
#define MR_CONSUME(c) do { if (w < 4) { const PG8_LAS unsigned char* sp = lds + ((c) & (NS - 1)) * SLOT; \
            const bf16x8 a0 = *(const PG8_LAS bf16x8*)(sp + aoff + x0), a1 = *(const PG8_LAS bf16x8*)(sp + aoff + x1); \
            _Pragma("unroll") for (int b = 0; b < 2; ++b) _Pragma("unroll") for (int n = 0; n < 2; ++n) { const int boff = (64 + 32 * b + 16 * n + fr) * 128; \
                const bf16x8 b0 = *(const PG8_LAS bf16x8*)(sp + boff + x0), b1 = *(const PG8_LAS bf16x8*)(sp + boff + x1); \
                acc[b][n] = __builtin_amdgcn_mfma_f32_16x16x32_bf16(b0, a0, acc[b][n], 0, 0, 0); \
                acc[b][n] = __builtin_amdgcn_mfma_f32_16x16x32_bf16(b1, a1, acc[b][n], 0, 0, 0); } \
            asm volatile("s_waitcnt lgkmcnt(0)" ::: "memory"); } } while (0)
    const int nmain = nchunk - PD;
#pragma unroll 1
    for (int c = 0; c < nmain; ++c) {
        MR_ISSUE(c + PD);
        asm volatile("s_waitcnt vmcnt(12)" ::: "memory"); __builtin_amdgcn_s_barrier(); asm volatile("" ::: "memory");
        MR_CONSUME(c);
    }
    asm volatile("s_waitcnt vmcnt(10)" ::: "memory"); __builtin_amdgcn_s_barrier(); asm volatile("" ::: "memory"); MR_CONSUME(nmain);
    asm volatile("s_waitcnt vmcnt(8)" ::: "memory"); __builtin_amdgcn_s_barrier(); asm volatile("" ::: "memory"); MR_CONSUME(nmain + 1);
    asm volatile("s_waitcnt vmcnt(6)" ::: "memory"); __builtin_amdgcn_s_barrier(); asm volatile("" ::: "memory"); MR_CONSUME(nmain + 2);
    asm volatile("s_waitcnt vmcnt(4)" ::: "memory"); __builtin_amdgcn_s_barrier(); asm volatile("" ::: "memory"); MR_CONSUME(nmain + 3);
    asm volatile("s_waitcnt vmcnt(2)" ::: "memory"); __builtin_amdgcn_s_barrier(); asm volatile("" ::: "memory"); MR_CONSUME(nmain + 4);
    asm volatile("s_waitcnt vmcnt(0)" ::: "memory"); __builtin_amdgcn_s_barrier(); asm volatile("" ::: "memory"); MR_CONSUME(nmain + 5);
#undef MR_CONSUME
#undef MR_ISSUE
    asm volatile("s_waitcnt vmcnt(0) lgkmcnt(0)" ::: "memory"); __builtin_amdgcn_s_barrier(); asm volatile("" ::: "memory");
    if (w < 4) {
        f32x4 big[2][2][4][2];
#pragma unroll
        for (int m = 0; m < 4; ++m)
#pragma unroll
            for (int bj = 0; bj < 2; ++bj)
#pragma unroll
                for (int n = 0; n < 2; ++n) { big[0][bj][m][n] = acc[bj][n]; big[1][bj][m][n] = (f32x4){0.f, 0.f, 0.f, 0.f}; }
        Unit u; u.pm = MP_ / BM; u.pn = j;
        E(big, u, rsel, wc, fr, fq, 1 << w, lds + EPV_OFF);
    }
    asm volatile("s_waitcnt lgkmcnt(0)" ::: "memory"); __builtin_amdgcn_s_barrier(); asm volatile("" ::: "memory");
}
__device__ __forceinline__ void glds16_asm(const void* gsrc, unsigned lds_dst) { unsigned keep;
    asm volatile("s_mov_b32 %0, m0\n\ts_mov_b32 m0, %2\n\ts_nop 0\n\tglobal_load_lds_dwordx4 %1, off\n\ts_mov_b32 m0, %0" : "=&s"(keep) : "v"(gsrc), "s"(lds_dst) : "memory"); }
typedef float f32x2_z __attribute__((ext_vector_type(2)));
__device__ __forceinline__ f32x4 zero4_pk() { f32x2_z a, b; asm volatile("v_pk_mov_b32 %0, 0, 0" : "=v"(a)); asm volatile("v_pk_mov_b32 %0, 0, 0" : "=v"(b)); return (f32x4){a.x, a.y, b.x, b.y}; }
template <class Epi, class Sched, bool ALIGN_EPI = false, bool SP2 = false>
__device__ __forceinline__ void gemm_phase(PG8_LAS unsigned char* lds, const Gemm g, const Sched& S, const Epi& E, int wave_u) {
    int tid_ = wave_u * 64 + lane_id_now(); asm volatile("" : "+v"(tid_));
    const int tid = tid_, wid = __builtin_amdgcn_readfirstlane(tid >> 6), lane = tid & 63, wr = wid >> 2, wc = wid & 3, fr = lane & 15, fq = lane >> 4;
    const int K = g.K, nt = K / BK;
    unsigned voffA[2], voffB[2];
#pragma unroll
    for (int i = 0; i < 2; ++i) { int R, C; stage_rc(tid * 16 + i * 8192, R, C); const int Rb = Epi::PERM ? ((R & ~31) + perm32(R & 31)) : R;
        voffA[i] = (unsigned)(R * K + C) * 2u; voffB[i] = (unsigned)(Rb * K + C) * 2u; }
    const size_t kstep = (size_t)(BK * 2);
    const size_t hstep = (size_t)HALF * K * 2;
    const size_t tstep = 2 * hstep;
    const unsigned ldsw = (unsigned)wid * 1024u;
    const unsigned ldsb = (unsigned)__builtin_amdgcn_readfirstlane((int)((unsigned)(size_t)lds + ldsw));
    const int aoff = lds_byte(wr * 64 + fr, fq * 8), boff = lds_byte(wc * 32 + fr, fq * 8);
#define PG8_SA(b, h) (((b) * 2 + (h)) * HTB)
#define PG8_SB(b, h) ((4 + (b) * 2 + (h)) * HTB)
#define PG8_STAGE(bufoff, gbase, voff) do { _Pragma("unroll") for (int _i = 0; _i < 2; ++_i) \
        glds16_asm((const char*)(gbase) + (voff)[_i], ldsb + (unsigned)((bufoff) + _i * 8192)); } while (0)
#define PG8_LDA(dst, b, h) do { _Pragma("unroll") for (int m = 0; m < 4; ++m) _Pragma("unroll") for (int k = 0; k < 2; ++k) dst[m][k] = *(const PG8_LAS bf16x8*)(lds + PG8_SA(b, h) + aoff + m * 2048 + k * 1024); } while (0)
#define PG8_LDB(dst, b, h) do { _Pragma("unroll") for (int n = 0; n < 2; ++n) _Pragma("unroll") for (int k = 0; k < 2; ++k) dst[n][k] = *(const PG8_LAS bf16x8*)(lds + PG8_SB(b, h) + boff + n * 2048 + k * 1024); } while (0)
#define PG8_MMA(ai, bj, At, Bt) do { __builtin_amdgcn_s_setprio(1); _Pragma("unroll") for (int m = 0; m < 4; ++m) _Pragma("unroll") for (int n = 0; n < 2; ++n) _Pragma("unroll") for (int k = 0; k < 2; ++k) \
        acc[ai][bj][m][n] = __builtin_amdgcn_mfma_f32_16x16x32_bf16(Bt[n][k], At[m][k], acc[ai][bj][m][n], 0, 0, 0); __builtin_amdgcn_s_setprio(0); } while (0)
#define PG8_WAIT_V(n) asm volatile("s_waitcnt vmcnt(" #n ")" ::: "memory")
#define PG8_WAIT_L(n) asm volatile("s_waitcnt lgkmcnt(" #n ")" ::: "memory")
#define PG8_BAR __builtin_amdgcn_s_barrier()
#define PG8_SCHED __builtin_amdgcn_sched_barrier(0)
    const unsigned evb = (unsigned)__builtin_amdgcn_readfirstlane((int)((unsigned)(size_t)lds + (unsigned)EPV_OFF + (unsigned)wid * 256u));
    Unit cur, nxt; int ui = 0;
    if (!S.next(0, cur)) return;
    f32x4 acc[2][2][4][2];
#pragma unroll
    for (int a = 0; a < 2; ++a)
#pragma unroll
        for (int b = 0; b < 2; ++b)
#pragma unroll
            for (int m = 0; m < 4; ++m)
#pragma unroll
                for (int n = 0; n < 2; ++n) acc[a][b][m][n] = zero4_pk();
    bf16x8 At[4][2], B0[2][2], B1[2][2];
    const char* cA = (const char*)g.A + (size_t)cur.pm * tstep; const char* cB = (const char*)g.Bt + (size_t)cur.pn * tstep;
    S.a_ready(cur);
    epi_prefetch(E, cur.pm, cur.pn, evb, tid);
    if constexpr (SP2) {
        PG8_STAGE(PG8_SB(0, 0), cB, voffB); PG8_STAGE(PG8_SB(0, 1), cB + hstep, voffB); PG8_STAGE(PG8_SA(0, 0), cA, voffA); PG8_STAGE(PG8_SA(0, 1), cA + hstep, voffA);
        if (wr == 1) PG8_BAR;
        PG8_WAIT_V(2); PG8_BAR;
        PG8_STAGE(PG8_SB(1, 0), cB + kstep, voffB); PG8_STAGE(PG8_SA(1, 0), cA + kstep, voffA); PG8_STAGE(PG8_SB(1, 1), cB + hstep + kstep, voffB);
        PG8_WAIT_V(6); PG8_BAR;
    } else {
        PG8_STAGE(PG8_SB(0, 0), cB, voffB); PG8_STAGE(PG8_SA(0, 0), cA, voffA); PG8_STAGE(PG8_SB(0, 1), cB + hstep, voffB); PG8_STAGE(PG8_SA(0, 1), cA + hstep, voffA);
        if (wr == 1) PG8_BAR;
        PG8_WAIT_V(4); PG8_BAR;
        PG8_STAGE(PG8_SB(1, 0), cB + kstep, voffB); PG8_STAGE(PG8_SA(1, 0), cA + kstep, voffA); PG8_STAGE(PG8_SB(1, 1), cB + hstep + kstep, voffB);
        PG8_WAIT_V(6); PG8_BAR;
    }
    for (;;) {
        const bool has_next = S.next(ui + 1, nxt);
        const char* nA = has_next ? (const char*)g.A + (size_t)nxt.pm * tstep : cA; const char* nB = has_next ? (const char*)g.Bt + (size_t)nxt.pn * tstep : cB;
        for (int t = 0; t < nt; t += 2) {
            const bool last = (t == nt - 2);
            const char* a1 = cA + (size_t)(t + 1) * kstep;
            const char* a2 = last ? nA : cA + (size_t)(t + 2) * kstep; const char* b2 = last ? nB : cB + (size_t)(t + 2) * kstep;
            const char* a3 = a2 + kstep; const char* b3 = b2 + kstep;
            if (last && has_next) { S.a_ready(nxt); epi_prefetch(E, nxt.pm, nxt.pn, evb + (unsigned)(((ui + 1) & 1) * EPV_BYTES), tid); }
            if constexpr (SP2) {
            PG8_LDB(B0, 0, 0); PG8_LDB(B1, 0, 1); PG8_SCHED; PG8_LDA(At, 0, 0); PG8_STAGE(PG8_SA(1, 1), a1 + hstep, voffA);
            PG8_WAIT_V(8); PG8_WAIT_L(0); PG8_BAR; PG8_MMA(0, 0, At, B0); PG8_MMA(0, 1, At, B1); PG8_BAR; PG8_SCHED;
            PG8_LDA(At, 0, 1); PG8_STAGE(PG8_SB(0, 0), b2, voffB); PG8_STAGE(PG8_SB(0, 1), b2 + hstep, voffB); PG8_STAGE(PG8_SA(0, 0), a2, voffA);
            PG8_WAIT_V(8); PG8_WAIT_L(0); PG8_BAR; PG8_MMA(1, 0, At, B0); PG8_MMA(1, 1, At, B1); PG8_BAR; PG8_SCHED;
            PG8_LDB(B0, 1, 0); PG8_LDB(B1, 1, 1); PG8_SCHED; PG8_LDA(At, 1, 0); PG8_STAGE(PG8_SA(0, 1), a2 + hstep, voffA);
            PG8_WAIT_V(8); PG8_WAIT_L(0); PG8_BAR; PG8_MMA(0, 0, At, B0); PG8_MMA(0, 1, At, B1); PG8_BAR; PG8_SCHED;
            PG8_LDA(At, 1, 1); PG8_STAGE(PG8_SB(1, 0), b3, voffB); PG8_STAGE(PG8_SB(1, 1), b3 + hstep, voffB); PG8_STAGE(PG8_SA(1, 0), a3, voffA);
            PG8_WAIT_V(8); PG8_WAIT_L(0); PG8_BAR; PG8_MMA(1, 0, At, B0); PG8_MMA(1, 1, At, B1); PG8_BAR; PG8_SCHED;
            } else {
            PG8_LDB(B0, 0, 0); PG8_SCHED; PG8_LDA(At, 0, 0); PG8_STAGE(PG8_SA(1, 1), a1 + hstep, voffA);
            PG8_WAIT_L(8); PG8_BAR; PG8_WAIT_L(0); PG8_MMA(0, 0, At, B0); PG8_BAR; PG8_SCHED;
            PG8_LDB(B1, 0, 1); PG8_STAGE(PG8_SB(0, 0), b2, voffB);
            PG8_BAR; PG8_WAIT_L(0); PG8_MMA(0, 1, At, B1); PG8_BAR;
            PG8_LDA(At, 0, 1); PG8_STAGE(PG8_SA(0, 0), a2, voffA);
            PG8_BAR; PG8_WAIT_L(0); PG8_MMA(1, 0, At, B0); PG8_BAR; PG8_SCHED;
            PG8_STAGE(PG8_SB(0, 1), b2 + hstep, voffB);
            PG8_WAIT_V(6); PG8_BAR; PG8_MMA(1, 1, At, B1); PG8_BAR;
            PG8_LDB(B0, 1, 0); PG8_SCHED; PG8_LDA(At, 1, 0); PG8_STAGE(PG8_SA(0, 1), a2 + hstep, voffA);
            PG8_WAIT_L(8); PG8_BAR; PG8_WAIT_L(0); PG8_MMA(0, 0, At, B0); PG8_BAR; PG8_SCHED;
            PG8_LDB(B1, 1, 1); PG8_STAGE(PG8_SB(1, 0), b3, voffB);
            PG8_BAR; PG8_WAIT_L(0); PG8_MMA(0, 1, At, B1); PG8_BAR;
            PG8_LDA(At, 1, 1); PG8_STAGE(PG8_SA(1, 0), a3, voffA);
            PG8_BAR; PG8_WAIT_L(0); PG8_MMA(1, 0, At, B0); PG8_BAR; PG8_SCHED;
            PG8_STAGE(PG8_SB(1, 1), b3 + hstep, voffB);
            PG8_WAIT_V(6); PG8_BAR; PG8_MMA(1, 1, At, B1); PG8_BAR;
            }
        }
        if constexpr (ALIGN_EPI) { if (wr == 0) PG8_BAR; }
        if constexpr (!Epi::AFTER_DRAIN) { E(acc, cur, wr, wc, fr, fq, 0xFF, lds + EPV_OFF + (ui & 1) * EPV_BYTES); S.done(cur); }
        if (!has_next) break;
#pragma unroll
        for (int a = 0; a < 2; ++a)
#pragma unroll
            for (int b = 0; b < 2; ++b)
#pragma unroll
                for (int m = 0; m < 4; ++m)
#pragma unroll
                    for (int n = 0; n < 2; ++n) acc[a][b][m][n] = zero4_pk();
        cur = nxt; cA = nA; cB = nB; ++ui;
        if constexpr (ALIGN_EPI) { if (wr == 1) PG8_BAR; }
    }
    PG8_WAIT_V(0);
    if constexpr (!ALIGN_EPI) { if (wr == 0) PG8_BAR; }
    PG8_BAR;
    if constexpr (Epi::AFTER_DRAIN) { E.fused(acc, cur, wr, wc, fr, fq, lds, wid, lane); S.done(cur); }
#undef PG8_SA
#undef PG8_SB
#undef PG8_STAGE
#undef PG8_LDA
#undef PG8_LDB
#undef PG8_MMA
#undef PG8_WAIT_V
#undef PG8_WAIT_L
#undef PG8_BAR
#undef PG8_SCHED
}
}

constexpr int NWAVES = 8;
constexpr int D = 1024, NB = 8, SEQ = 2048, DEC = 128, MP = NB * SEQ, MT = MP + DEC, MTP = 16640  ;
constexpr int HW = 512, NH = 4, DK = 128, DV = 128, CW = 512, CK = 31, DFF = 2816, EIN = 3072, NUP = 2 * DFF;
constexpr float LN_EPS = 1e-5f, RMS_EPS = 1e-6f;
constexpr size_t MiB = 1u << 20;
constexpr size_t WS_CTL = 0, CTL_ZERO_BYTES = 4 * MiB;
constexpr size_t WS_ZEROS = 512 * 1024;
constexpr size_t WS_STATS = 1 * MiB, STATS_BYTES = (size_t)MTP * 8;
constexpr size_t WS_SMALL = 3 * MiB;
constexpr size_t WS_STATS0 = WS_SMALL, WS_ONES = WS_SMALL + 256 * 1024, WS_LBS = WS_ONES + 4096, WS_CVEC = WS_SMALL + 512 * 1024;
constexpr size_t CVEC_LAYER = (size_t)(EIN + NUP) * 2;
constexpr size_t WS_W = 4 * MiB, W_LAYER = 49 * MiB / 2;
constexpr size_t W_IN = 0, W_OUT = 6 * MiB, W_13 = 8 * MiB, W_2 = 19 * MiB;
constexpr size_t WS_ZA = 102 * MiB, WS_ZB = 135 * MiB, WS_A2 = 168 * MiB, WS_PH = 201 * MiB, WS_TMP = 291 * MiB, WS_END = 324 * MiB;
static_assert(WS_STATS + 8 * STATS_BYTES <= WS_SMALL && WS_CVEC + 4 * CVEC_LAYER * 4 <= WS_W && WS_W + 4 * W_LAYER <= WS_ZA && WS_ZA + (size_t)MTP * D * 2 <= WS_ZB && WS_ZB + (size_t)MTP * D * 2 <= WS_A2 &&
              WS_A2 + (size_t)MTP * D * 2 <= WS_PH && WS_PH + (size_t)MTP * DFF * 2 <= WS_TMP && WS_TMP + (size_t)MTP * HW * 4 <= WS_END, "d_ws map");
constexpr int CW_TMO = 0, CW_CODE = 1, CW_BAR = 4096, CW_SCTR = 160 * 1024;
constexpr int RING_OFF = 0, RING_BYTES = 131072, LDSCTL_OFF = RING_BYTES, MISC_OFF = LDSCTL_OFF + 320, LDS_BYTES = 147456;
static_assert(pg8::EPV_OFF >= MISC_OFF + 256 && pg8::EPV_OFF + 2 * pg8::EPV_BYTES <= LDS_BYTES, "epilogue-vector buffers live above the ring and the barrier words");
#define GAS __attribute__((address_space(1)))
#define LAS __attribute__((address_space(3)))
typedef unsigned short bf16;
typedef unsigned v4u __attribute__((ext_vector_type(4)));
typedef unsigned v2u __attribute__((ext_vector_type(2)));
typedef float f32x4 __attribute__((ext_vector_type(4)));
typedef GAS unsigned gu32;
#define RLX_AGENT __ATOMIC_RELAXED, __HIP_MEMORY_SCOPE_AGENT
#define LDS_WAIT() asm volatile("s_waitcnt lgkmcnt(0)" ::: "memory")
#define VM_WAIT() asm volatile("s_waitcnt vmcnt(0)" ::: "memory")
typedef float f32x2_cv __attribute__((ext_vector_type(2)));
typedef __bf16 bf16x2_cv __attribute__((ext_vector_type(2)));
__device__ __forceinline__ unsigned pk2(float lo, float hi) { const f32x2_cv v = {lo, hi}; const bf16x2_cv b = __builtin_convertvector(v, bf16x2_cv); return __builtin_bit_cast(unsigned, b); }
__device__ __forceinline__ unsigned f2bf(float f) { return pk2(f, 0.f) & 0xffffu; }
__device__ __forceinline__ float bfr(float f) { return __uint_as_float(f2bf(f) << 16); }
__device__ __forceinline__ float b2f(bf16 b) { return __uint_as_float((unsigned)b << 16); }
#define XB_TMO      128
#define XB_XCNT(j)  (256  + 64 * (j))
#define XB_XSUB(j)  (1280 + 64 * (j))
#define XB_XGEN(j)  (2304 + 64 * (j))
#define XB_TOP      3328
#define XB_TOPGEN   3392
#define XCD_BAR_WORDS 3456
#define XB_SPIN_CAP (1u << 18)

__device__ __forceinline__ unsigned xb_ld(unsigned* p)              { return __hip_atomic_load(p, __ATOMIC_RELAXED, __HIP_MEMORY_SCOPE_AGENT); }
__device__ __forceinline__ unsigned xb_add(unsigned* p, unsigned v) { return __hip_atomic_fetch_add(p, v, __ATOMIC_RELAXED, __HIP_MEMORY_SCOPE_AGENT); }
__device__ __forceinline__ unsigned xb_xcc_id() { return (unsigned)__builtin_amdgcn_s_getreg((3 << 11) | 20) & 0xFu; }
#define XB_SPIN(cond, bar) do { unsigned _sp = 0; while (cond) { __builtin_amdgcn_s_sleep(1); \
    if ((++_sp & 255u) == 0u) { if (xb_ld(&(bar)[XB_TMO])) break; if (_sp > XB_SPIN_CAP) { atomicAdd(&(bar)[XB_TMO], 1u); break; } } } } while (0)

struct XcdBarrier {
    unsigned* bar; unsigned x;
    volatile LAS unsigned* st;
};

__device__ __forceinline__ XcdBarrier xcd_barrier_post(unsigned* bar, volatile LAS unsigned* st) {
    XcdBarrier b; b.bar = bar; b.x = xb_xcc_id(); b.st = st;
    if (threadIdx.x == 0) (void)xb_add(&bar[XB_XCNT(b.x)], 1u);
    return b;
}
__device__ __forceinline__ void xcd_barrier_complete(unsigned* bar, unsigned x, unsigned& nloc, unsigned& nx) {
    const unsigned G = gridDim.x * gridDim.y * gridDim.z;
    unsigned sum, cnt, mine, sp = 0u;
    for (;;) {
        sum = 0u; cnt = 0u; mine = 0u;
#pragma unroll
        for (unsigned j = 0; j < 16; ++j) { const unsigned c = xb_ld(&bar[XB_XCNT(j)]); sum += c; cnt += (c > 0u) ? 1u : 0u; mine = (j == x) ? c : mine; }
        if (sum == G) break;
        __builtin_amdgcn_s_sleep(1);
        if ((++sp & 255u) == 0u) { if (xb_ld(&bar[XB_TMO])) break; if (sp > XB_SPIN_CAP) { atomicAdd(&bar[XB_TMO], 1u); break; } }
    }
    nloc = mine > 0u ? mine : 1u; nx = cnt > 0u ? cnt : 1u;
}

__device__ __forceinline__ void xcd_barrier(const XcdBarrier& b) {
    asm volatile("s_waitcnt vmcnt(0)" ::: "memory");
    __syncthreads();
    if (threadIdx.x == 0) {
        unsigned* bar = b.bar;
        __builtin_amdgcn_s_waitcnt(0);
        unsigned nloc = b.st[0], nx = b.st[1];
        if (nloc == 0u) { xcd_barrier_complete(bar, b.x, nloc, nx); b.st[0] = nloc; b.st[1] = nx; }
        const unsigned old = xb_add(&bar[XB_XSUB(b.x)], 1u);
        const unsigned gen = old / nloc;
        if (old + 1u == (gen + 1u) * nloc) {
            __builtin_amdgcn_fence(__ATOMIC_RELEASE, "agent");
            asm volatile("buffer_inv sc1" ::: "memory");
            asm volatile("s_waitcnt vmcnt(0)" ::: "memory");
            const unsigned og = xb_add(&bar[XB_TOP], 1u);
            const unsigned tg = og / nx;
            if (og + 1u == (tg + 1u) * nx) {
#pragma unroll
                for (unsigned j = 0; j < 16; ++j) (void)xb_add(&bar[XB_XGEN(j)], 1u);
            } else XB_SPIN(xb_ld(&bar[XB_XGEN(b.x)]) == gen, bar);
            __builtin_amdgcn_fence(__ATOMIC_ACQUIRE, "workgroup");
            asm volatile("s_waitcnt vmcnt(0)" ::: "memory");
        } else {
            asm volatile("buffer_inv sc1" ::: "memory");
            XB_SPIN(xb_ld(&bar[XB_XGEN(b.x)]) == gen, bar);
            __builtin_amdgcn_fence(__ATOMIC_ACQUIRE, "workgroup");
            asm volatile("s_waitcnt vmcnt(0)" ::: "memory");
        }
    }
    __syncthreads();
}
struct Args { const float* in[23]; float* out; unsigned char* ws; int ph_lo, ph_hi, li, pad; };
struct Frame { LAS unsigned char* lds; int tid, lane, wave, vcu, G; };
__device__ __forceinline__ Frame phase_frame(const Frame& F0) { Frame F = F0; int t = F0.wave * 64 + lane_id_now(); asm volatile("" : "+v"(t)); F.tid = t; F.lane = t & 63; F.wave = F0.wave; return F; }

struct PItem { const float* W; int N, K; const float* g; const float* be; bf16* WT; int drow0, k0, n0; float* c1; float* c2; };
__device__ __forceinline__ void p0_item_load(const PItem& it, int lane, f32x4 (&v)[8]) {
#pragma unroll
    for (int i = 0; i < 8; ++i) v[i] = *(const GAS f32x4*)(it.W + (size_t)(it.k0 + 8 * i + (lane >> 3)) * it.N + it.n0 + 4 * (lane & 7));
}
__device__ __forceinline__ void p0_item_process(const PItem& it, int lane, const f32x4 (&v)[8], LAS float* scr) {
    LAS float* gl = scr + 64 * 36 + 32; LAS float* bl = gl + 64;
#define SCR_ROW(r) ((r) * 36 + 4 * ((r) >> 3))
#pragma unroll
    for (int i = 0; i < 8; ++i) *(LAS f32x4*)(scr + SCR_ROW(8 * i + (lane >> 3)) + 4 * (lane & 7)) = v[i];
    gl[lane] = it.g ? it.g[it.k0 + lane] : 1.f; bl[lane] = it.be ? it.be[it.k0 + lane] : 0.f;
    LDS_WAIT(); asm volatile("" ::: "memory");
    if (it.c1) { const int n = lane & 31, kh = lane >> 5; float s1 = 0.f, s2 = 0.f;
#pragma unroll 8
        for (int kk = 0; kk < 32; ++kk) { const int k = 32 * kh + kk; const float x = scr[SCR_ROW(k) + n]; s1 += bfr(gl[k] * x); s2 += bl[k] * x; }
        s1 += __shfl_xor(s1, 32); s2 += __shfl_xor(s2, 32);
        if (lane < 32) { atomicAdd(it.c1 + it.drow0 + n, s1); if (it.be) atomicAdd(it.c2 + it.drow0 + n, s2); } }
    const int c = lane & 7;
    const f32x4 g0 = *(const LAS f32x4*)(gl + 8 * c), g1 = *(const LAS f32x4*)(gl + 8 * c + 4);
#pragma unroll
    for (int j = 0; j < 4; ++j) { const int n = (lane >> 3) + 8 * j; const LAS float* sp = scr + SCR_ROW(8 * c) + n;
        v4u o; o.x = pk2(sp[0 * 36] * g0[0], sp[1 * 36] * g0[1]); o.y = pk2(sp[2 * 36] * g0[2], sp[3 * 36] * g0[3]); o.z = pk2(sp[4 * 36] * g1[0], sp[5 * 36] * g1[1]); o.w = pk2(sp[6 * 36] * g1[2], sp[7 * 36] * g1[3]);
        *(GAS v4u*)(it.WT + (size_t)(it.drow0 + n) * it.K + it.k0 + 8 * c) = o; }
    LDS_WAIT(); asm volatile("" ::: "memory");
}
__device__ __forceinline__ int in_src_col(int j, int odd) {
    const int jt = j >> 8, jo = j & 255, nplain = odd ? 4 : 8;
    if (jt < nplain) return j;
    const int i = jt - nplain, first = odd ? 1024 : 2048, second = odd ? 2048 : 2560;
    return (jo < 128) ? first + 128 * i + jo : second + 128 * i + (jo - 128);
}
__device__ __forceinline__ int in_dst_row(int n, int odd) {
    const int first = odd ? 1024 : 2048, second = odd ? 2048 : 2560;
    if (n < first) return n;
    if (n < second) { const int i = (n - first) >> 7, o = (n - first) & 127; return first + 256 * i + o; }
    const int i = (n - second) >> 7, o = (n - second) & 127; return first + 256 * i + 128 + o;
}
__device__ __forceinline__ PItem p0_decode(const Args& a, int it) {
    constexpr int I_IN = 16 * 96, I_OUT = 16 * 32, I_W1 = 16 * 88, I_W2 = 44 * 32, I_LAYER = I_IN + I_OUT + 2 * I_W1 + I_W2;
    const int l = it / I_LAYER, e = l >> 1, odd = l & 1; int r = it % I_LAYER;
    unsigned char* wl = a.ws + WS_W + (size_t)l * W_LAYER; float* cv = (float*)(a.ws + WS_CVEC) + (size_t)l * CVEC_LAYER;
    PItem p;
    if (r < I_IN) { const int kb = r / 96, nb = r % 96; p.W = (odd ? a.in[13] : a.in[5]) + (size_t)e * D * EIN; p.N = EIN; p.K = D; p.g = l > 0 ? a.in[21] + (size_t)(l - 1) * D : nullptr; p.be = l > 0 ? a.in[22] + (size_t)(l - 1) * D : nullptr;
        p.WT = (bf16*)(wl + W_IN); p.drow0 = in_dst_row(32 * nb, odd); p.k0 = 64 * kb; p.n0 = 32 * nb; p.c1 = cv; p.c2 = cv + EIN; return p; } r -= I_IN;
    if (r < I_OUT) { const int kb = r / 32, nb = r % 32; p.W = (odd ? a.in[15] : a.in[6]) + (size_t)e * D * D; p.N = D; p.K = D; p.g = nullptr; p.be = nullptr;
        p.WT = (bf16*)(wl + W_OUT); p.drow0 = 32 * nb; p.k0 = 64 * kb; p.n0 = 32 * nb; p.c1 = nullptr; p.c2 = nullptr; return p; } r -= I_OUT;
    if (r < 2 * I_W1) { const int second = r >= I_W1; if (second) r -= I_W1; const int kb = r / 88, nb = r % 88, n0 = 32 * nb; p.W = (second ? a.in[17] : a.in[16]) + (size_t)l * D * DFF; p.N = DFF; p.K = D;
        p.g = a.in[19] + (size_t)l * D; p.be = a.in[20] + (size_t)l * D; p.WT = (bf16*)(wl + W_13); p.drow0 = 256 * (n0 >> 7) + (second ? 128 : 0) + (n0 & 127); p.k0 = 64 * kb; p.n0 = n0; p.c1 = cv + 2 * EIN; p.c2 = cv + 2 * EIN + NUP; return p; } r -= 2 * I_W1;
    { const int kb = r / 32, nb = r % 32; p.W = a.in[18] + (size_t)l * DFF * D; p.N = D; p.K = DFF; p.g = nullptr; p.be = nullptr; p.WT = (bf16*)(wl + W_2); p.drow0 = 32 * nb; p.k0 = 64 * kb; p.n0 = 32 * nb; p.c1 = nullptr; p.c2 = nullptr; return p; }
}
__device__ __forceinline__ void p0_convert(const Frame& F, const Args& a, int it_lo, int it_hi, int widx, int nw, LAS float* scr) {
    const int it0 = it_lo + widx, itend = it_hi;
    if (it0 < itend) {
        PItem cur = p0_decode(a, it0); f32x4 vc[8]; p0_item_load(cur, F.lane, vc);
        for (int it = it0; it < itend; it += nw) {
            const bool more = it + nw < itend;
            PItem nxt = cur; f32x4 vn[8];
            if (more) { nxt = p0_decode(a, it + nw); p0_item_load(nxt, F.lane, vn); }
            p0_item_process(cur, F.lane, vc, scr);
            if (more) { cur = nxt;
#pragma unroll
                for (int i = 0; i < 8; ++i) vc[i] = vn[i]; }
        }
    }
}
constexpr int P_ILAYER = 16 * 96 + 16 * 32 + 2 * 16 * 88 + 44 * 32, P_IIN = 16 * 96, P_IW2 = 44 * 32;
__device__ __forceinline__ void p_convert_tail(const Frame& F0, const Args& a, int it_lo, int it_hi, int wg_idx, int n_wgs) {
    const Frame F = phase_frame(F0);
    p0_convert(F, a, it_lo, it_hi, wg_idx * NWAVES + F.wave, n_wgs * NWAVES, (LAS float*)(F.lds + RING_OFF + F.wave * 16384));
}
__device__ __forceinline__ void p_state_copies_tail(const Frame& F0, const Args& a, int wg_idx, int n_wgs) {
    const Frame F = phase_frame(F0);
    const size_t gt = ((size_t)wg_idx * NWAVES + F.wave) * 64 + F.lane, NGT = (size_t)n_wgs * NWAVES * 64;
    float* o_cs = a.out + (size_t)MT * D + (size_t)2 * NB * NH * DK * DV + (size_t)2 * NB * 30 * CW + (size_t)2 * NB * 2 * D + (size_t)2 * DEC * NH * DK * DV;
    float* o_ss = o_cs + (size_t)2 * DEC * 30 * CW;
    constexpr size_t NC = (size_t)2 * DEC * 29 * (CW / 4);
    for (size_t i0 = gt; i0 < NC; i0 += 4 * NGT) { f32x4 t[4];
#pragma unroll
        for (int q = 0; q < 4; ++q) { const size_t i = i0 + q * NGT; if (i < NC) { const size_t c4 = i % (CW / 4), r = i / (CW / 4), ii = r % 29, eb = r / 29; t[q] = *(const f32x4*)(a.in[3] + (eb * 30 + ii + 1) * CW + c4 * 4); } }
#pragma unroll
        for (int q = 0; q < 4; ++q) { const size_t i = i0 + q * NGT; if (i < NC) { const size_t c4 = i % (CW / 4), r = i / (CW / 4), ii = r % 29, eb = r / 29; *(f32x4*)(o_cs + (eb * 30 + ii) * CW + c4 * 4) = t[q]; } } }
    for (size_t i = gt; i < (size_t)2 * DEC * (D / 4); i += NGT) { const size_t c4 = i % (D / 4), eb = i / (D / 4);
        *(f32x4*)(o_ss + (eb * 2 + 0) * D + c4 * 4) = *(const f32x4*)(a.in[4] + (eb * 2 + 1) * D + c4 * 4); }
}
__device__ __forceinline__ void p0_prologue(const Frame& F0, const Args& a) {
    const Frame F = phase_frame(F0);
    unsigned char* ws = a.ws;
    LAS float* scr = (LAS float*)(F.lds + RING_OFF + F.wave * 16384);
    const int gw = F.vcu * NWAVES + F.wave, NGW = F.G * NWAVES;
    p0_convert(F, a, 0, 16 * 96, gw, NGW, scr);
    for (int m0 = gw; m0 < MTP; m0 += 4 * NGW) {
        f32x4 v[4][4];
#pragma unroll
        for (int q = 0; q < 4; ++q) { const int m = m0 + q * NGW;
            if (m < MT) { const GAS f32x4* xr = (const GAS f32x4*)(m < MP ? a.in[0] + (size_t)m * D : a.in[1] + (size_t)(m - MP) * D) + F.lane;
#pragma unroll
                for (int j = 0; j < 4; ++j) v[q][j] = xr[64 * j]; }
            else {
#pragma unroll
                for (int j = 0; j < 4; ++j) v[q][j] = (f32x4){0.f, 0.f, 0.f, 0.f}; } }
#pragma unroll
        for (int q = 0; q < 4; ++q) { const int m = m0 + q * NGW;
            if (m < MTP) { GAS unsigned long long* o8 = (GAS unsigned long long*)((bf16*)(ws + WS_ZA) + (size_t)m * D) + F.lane;
#pragma unroll
                for (int j = 0; j < 4; ++j) o8[64 * j] = (unsigned long long)pk2(v[q][j].x, v[q][j].y) | ((unsigned long long)pk2(v[q][j].z, v[q][j].w) << 32); } }
    }
    const size_t gt = (size_t)gw * 64 + F.lane, NGT = (size_t)NGW * 64;
    for (size_t i = gt; i < (size_t)MTP; i += NGT) { float* s0 = (float*)(ws + WS_STATS0) + 2 * i; s0[0] = 0.f; s0[1] = 1024.f * (1.f - LN_EPS); }
    for (size_t i = gt; i < 1024; i += NGT) { ((float*)(ws + WS_ONES))[i] = 1.f;
        const int c = (int)i & 511; const float l0 = a.in[7][c], l1 = a.in[7][HW + c], mx = fmaxf(l0, l1), e0 = expf(l0 - mx), e1 = expf(l1 - mx);
        ((float*)(ws + WS_LBS))[i] = (i < 512) ? 0.f : e1 / (e0 + e1); }
}
__device__ __forceinline__ void sample_publish(const Frame& F0, unsigned* ctr, unsigned n) {
    if (F0.wave == 0 && lane_id_now() == 0) {
        __builtin_amdgcn_fence(__ATOMIC_RELEASE, "agent");
        asm volatile("s_waitcnt vmcnt(0)" ::: "memory");
        (void)__hip_atomic_fetch_add(ctr, n, __ATOMIC_RELAXED, __HIP_MEMORY_SCOPE_AGENT);
    }
}
__device__ __forceinline__ void sample_wait(const Frame& F0, unsigned* ctr, unsigned want) {
    if (F0.wave == 0 && lane_id_now() == 0) {
        unsigned sp = 0u;
        while (__hip_atomic_load(ctr, __ATOMIC_RELAXED, __HIP_MEMORY_SCOPE_AGENT) < want) { __builtin_amdgcn_s_sleep(2); if (++sp > (1u << 20)) break; }
        __builtin_amdgcn_fence(__ATOMIC_ACQUIRE, "agent");
        asm volatile("s_waitcnt vmcnt(0)" ::: "memory");
    }
    __syncthreads();
}
__device__ __forceinline__ void p_final_ln(const Frame& F0, const Args& a) {
    const Frame F = phase_frame(F0);
    const int gw = F.vcu * NWAVES + F.wave, NGW = F.G * NWAVES;
    const float* st = (const float*)(a.ws + WS_STATS + 7 * STATS_BYTES); const float* w = a.in[21] + 3 * D; const float* b = a.in[22] + 3 * D;
    f32x4 wv[4], bv[4];
#pragma unroll
    for (int j = 0; j < 4; ++j) { wv[j] = *((const f32x4*)w + 64 * j + F.lane); bv[j] = *((const f32x4*)b + 64 * j + F.lane); }
    const bf16* Z = (const bf16*)(a.ws + WS_ZA);
    for (int m0 = gw; m0 < MT; m0 += 8 * NGW) {
        v2u v[8][4]; float rA[8], rB[8];
#pragma unroll
        for (int q = 0; q < 8; ++q) { const int m = m0 + q * NGW < MT ? m0 + q * NGW : MT - 1; pg8::ln_row(st, m, rA[q], rB[q]);
            const GAS v2u* xr = (const GAS v2u*)(Z + (size_t)m * D) + F.lane;
#pragma unroll
            for (int j = 0; j < 4; ++j) v[q][j] = xr[64 * j]; }
#pragma unroll
        for (int q = 0; q < 8; ++q) { const int m = m0 + q * NGW; if (m < MT) { GAS f32x4* xr = (GAS f32x4*)(a.out + (size_t)m * D) + F.lane;
#pragma unroll
            for (int j = 0; j < 4; ++j) { const f32x4 x = {pg8::bf_lo(v[q][j].x), pg8::bf_hi(v[q][j].x), pg8::bf_lo(v[q][j].y), pg8::bf_hi(v[q][j].y)}; xr[64 * j] = (x * rA[q] + rB[q]) * wv[j] + bv[j]; } } }
    }
}
typedef short bf16x8 __attribute__((ext_vector_type(8)));
constexpr int H_QT = 0, H_KT = 17408, H_KTT = 34816, H_VTT = 53248, H_P = 71680, H_ST = 80896, H_TOT = 115712, H_VEC = 117760;
constexpr int LDQ = 272, LD64 = 144;
constexpr size_t TMP_SF = 0, TMP_DS = 16 * MiB;
__device__ __forceinline__ f32x4 mfma16(bf16x8 a, bf16x8 b, f32x4 c) { return __builtin_amdgcn_mfma_f32_16x16x32_bf16(a, b, c, 0, 0, 0); }
__device__ __forceinline__ void hgrn_pass1(const Frame& F, unsigned char* ws) {
    bf16* PB = (bf16*)(ws + WS_PH);
    LAS unsigned char* L = F.lds + RING_OFF;
    const int k = F.tid & 127, qd = F.tid >> 7, w = F.wave, li = F.lane & 15, lq = F.lane >> 4;
    LAS float* TOT = (LAS float*)(L + H_TOT); LAS float* VEC = (LAS float*)(L + H_VEC);
    for (int unit = F.vcu; unit < 256; unit += F.G) {
        const int b = unit >> 5, h = (unit >> 3) & 3, seg = unit & 7, row_base = b * SEQ + seg * 256;
        f32x4 S[8];
#pragma unroll
        for (int vt = 0; vt < 8; ++vt) S[vt] = (f32x4){0.f, 0.f, 0.f, 0.f};
        float Bprev = 0.f;
        unsigned short rq[16], rl[16], rv[16];
        { const bf16* p0 = PB + (size_t)(row_base + qd * 16) * 2560 + h * 128 + k;
#pragma unroll
          for (int i = 0; i < 16; ++i) { const bf16* p = p0 + (size_t)i * 2560; rq[i] = p[0]; rl[i] = p[512]; rv[i] = p[1024]; } }
        for (int c = 0; c < 4; ++c) {
            bf16* prow = PB + (size_t)(row_base + c * 64 + qd * 16) * 2560 + h * 128 + k;
            float lf[16], qh[16]; unsigned vr[16];
#pragma unroll
            for (int i = 0; i < 16; ++i) { qh[i] = b2f(rq[i]); lf[i] = b2f(rl[i]); vr[i] = rv[i]; }
            if (c < 3) { const bf16* p0 = prow + (size_t)64 * 2560;
#pragma unroll
                for (int i = 0; i < 16; ++i) { const bf16* p = p0 + (size_t)i * 2560; rq[i] = p[0]; rl[i] = p[512]; rv[i] = p[1024]; } }
            float cs[16]; cs[0] = lf[0];
#pragma unroll
            for (int i = 1; i < 16; ++i) cs[i] = cs[i - 1] + lf[i];
            TOT[qd * 128 + k] = cs[15];
            __syncthreads();
            const float t0 = TOT[k], t1 = TOT[128 + k], t2 = TOT[256 + k], t3 = TOT[384 + k];
            const float off = (qd > 0 ? t0 : 0.f) + (qd > 1 ? t1 : 0.f) + (qd > 2 ? t2 : 0.f), bref = t0 + t1, btot = bref + t2 + t3;
            const float eqb = __expf(bref + Bprev);
            unsigned ktp[8], vtp[8];
#pragma unroll
            for (int i = 0; i < 16; ++i) {
                const float d = fminf(fmaxf(cs[i] + off - bref, -80.f), 80.f);
                const float E1 = __expf(d), E2 = __expf(-d), f = __expf(lf[i]);
                const float qt = qh[i] * E1, kt = (1.f - f) * E2;
                const int t = qd * 16 + i; const unsigned kb = f2bf(kt);
                *(LAS bf16*)(L + H_QT + t * LDQ + k * 2) = (bf16)f2bf(qt);
                *(LAS bf16*)(L + H_KT + t * LDQ + k * 2) = (bf16)kb;
                if (i & 1) { ktp[i >> 1] |= kb << 16; vtp[i >> 1] |= vr[i] << 16; } else { ktp[i >> 1] = kb; vtp[i >> 1] = vr[i]; }
                prow[(size_t)i * 2560] = (bf16)f2bf(qt * eqb);
            }
            *(LAS v4u*)(L + H_KTT + k * LD64 + qd * 32) = (v4u){ktp[0], ktp[1], ktp[2], ktp[3]}; *(LAS v4u*)(L + H_KTT + k * LD64 + qd * 32 + 16) = (v4u){ktp[4], ktp[5], ktp[6], ktp[7]};
            *(LAS v4u*)(L + H_VTT + k * LD64 + qd * 32) = (v4u){vtp[0], vtp[1], vtp[2], vtp[3]}; *(LAS v4u*)(L + H_VTT + k * LD64 + qd * 32 + 16) = (v4u){vtp[4], vtp[5], vtp[6], vtp[7]};
            if (qd == 0) { VEC[k] = __expf(bref); VEC[128 + k] = __expf(btot - bref); }
            Bprev += btot;
            __syncthreads();
            { const f32x4 eb = *(const LAS f32x4*)(VEC + 16 * w + 4 * lq);
#pragma unroll
              for (int vt = 0; vt < 8; ++vt) { S[vt] = S[vt] * eb;
                  *(LAS v2u*)(L + H_ST + (16 * vt + li) * LDQ + (16 * w + 4 * lq) * 2) = (v2u){pk2(S[vt][0], S[vt][1]), pk2(S[vt][2], S[vt][3])}; } }
            { const int ti = w >> 1;
#pragma unroll
              for (int q2 = 0; q2 < 2; ++q2) { const int si = 2 * (w & 1) + q2; f32x4 acc = {0.f, 0.f, 0.f, 0.f};
                  if (si <= ti) {
#pragma unroll
                      for (int ks = 0; ks < 4; ++ks) acc = mfma16(*(const LAS bf16x8*)(L + H_KT + (16 * si + li) * LDQ + (32 * ks + 8 * lq) * 2), *(const LAS bf16x8*)(L + H_QT + (16 * ti + li) * LDQ + (32 * ks + 8 * lq) * 2), acc);
                      if (si == ti) {
#pragma unroll
                          for (int r = 0; r < 4; ++r) if (4 * lq + r > li) acc[r] = 0.f; } }
                  *(LAS v2u*)(L + H_P + (16 * ti + li) * LD64 + (16 * si + 4 * lq) * 2) = (v2u){pk2(acc[0], acc[1]), pk2(acc[2], acc[3])}; } }
            __syncthreads();
            { const int ti = w & 3, vt0 = 4 * (w >> 2), nps = (ti >> 1) + 1;
              bf16x8 qf[4], pf[2];
#pragma unroll
              for (int ks = 0; ks < 4; ++ks) qf[ks] = *(const LAS bf16x8*)(L + H_QT + (16 * ti + li) * LDQ + (32 * ks + 8 * lq) * 2);
#pragma unroll
              for (int ks = 0; ks < 2; ++ks) pf[ks] = *(const LAS bf16x8*)(L + H_P + (16 * ti + li) * LD64 + (32 * ks + 8 * lq) * 2);
              bf16* orow = PB + (size_t)(row_base + c * 64 + 16 * ti + li) * 2560 + 1024 + h * 128 + 4 * lq;
#pragma unroll
              for (int j = 0; j < 4; ++j) { const int vrow = 16 * (vt0 + j) + li; f32x4 acc = {0.f, 0.f, 0.f, 0.f};
#pragma unroll
                  for (int ks = 0; ks < 4; ++ks) acc = mfma16(*(const LAS bf16x8*)(L + H_ST + vrow * LDQ + (32 * ks + 8 * lq) * 2), qf[ks], acc);
                  acc = mfma16(*(const LAS bf16x8*)(L + H_VTT + vrow * LD64 + (8 * lq) * 2), pf[0], acc);
                  if (nps > 1) acc = mfma16(*(const LAS bf16x8*)(L + H_VTT + vrow * LD64 + (32 + 8 * lq) * 2), pf[1], acc);
                  *(v2u*)(orow + 16 * (vt0 + j)) = (v2u){pk2(acc[0], acc[1]), pk2(acc[2], acc[3])}; } }
            { bf16x8 kf[2];
#pragma unroll
              for (int ks = 0; ks < 2; ++ks) kf[ks] = *(const LAS bf16x8*)(L + H_KTT + (16 * w + li) * LD64 + (32 * ks + 8 * lq) * 2);
              const f32x4 cf = *(const LAS f32x4*)(VEC + 128 + 16 * w + 4 * lq);
#pragma unroll
              for (int vt = 0; vt < 8; ++vt) {
#pragma unroll
                  for (int ks = 0; ks < 2; ++ks) S[vt] = mfma16(kf[ks], *(const LAS bf16x8*)(L + H_VTT + (16 * vt + li) * LD64 + (32 * ks + 8 * lq) * 2), S[vt]);
                  S[vt] = S[vt] * cf; } }
        }
        float* SF = (float*)(ws + WS_TMP + TMP_SF) + (size_t)unit * 16384;
#pragma unroll
        for (int vt = 0; vt < 8; ++vt)
#pragma unroll
            for (int r = 0; r < 4; ++r) SF[(16 * w + 4 * lq + r) * 128 + 16 * vt + li] = S[vt][r];
        if (qd == 0) ((float*)(ws + WS_TMP + TMP_DS))[unit * 128 + k] = __expf(Bprev);
        __syncthreads();
    }
}
__device__ __forceinline__ void hgrn_pass2(const Frame& F, unsigned char* ws, const float* gw, float* o_state  ) {
    bf16* PB = (bf16*)(ws + WS_PH); bf16* A2 = (bf16*)(ws + WS_A2);
    LAS unsigned char* L = F.lds + RING_OFF;
    const int w = F.wave, li = F.lane & 15, lq = F.lane >> 4, v4 = (F.tid & 31) * 4, kg = F.tid >> 5;
    const float* SFall = (const float*)(ws + WS_TMP + TMP_SF); const float* DSall = (const float*)(ws + WS_TMP + TMP_DS);
    for (int unit = F.vcu; unit < 256; unit += F.G) {
        const int b = unit >> 5, h = (unit >> 3) & 3, seg = unit & 7, row_base = b * SEQ + seg * 256;
        f32x4 Sin[8];
#pragma unroll
        for (int i = 0; i < 8; ++i) Sin[i] = (f32x4){0.f, 0.f, 0.f, 0.f};
        for (int j0 = 0; j0 < seg; j0 += 2) {
            f32x4 sf[2][8]; float dj[2][8];
#pragma unroll
            for (int jj = 0; jj < 2; ++jj) if (j0 + jj < seg) { const float* SFj = SFall + (size_t)(unit - seg + j0 + jj) * 16384; const float* Dj = DSall + (size_t)(unit - seg + j0 + jj) * 128;
#pragma unroll
                for (int i = 0; i < 8; ++i) { const int kk = kg * 8 + i; sf[jj][i] = *(const f32x4*)(SFj + kk * 128 + v4); dj[jj][i] = Dj[kk]; } }
#pragma unroll
            for (int jj = 0; jj < 2; ++jj) if (j0 + jj < seg) {
#pragma unroll
                for (int i = 0; i < 8; ++i) Sin[i] = Sin[i] * dj[jj][i] + sf[jj][i]; }
        }
        if (seg == 7) { const float* SF7 = SFall + (size_t)unit * 16384; const float* D7 = DSall + (size_t)unit * 128; float* dst = o_state + (size_t)(b * NH + h) * 16384;
#pragma unroll
            for (int i = 0; i < 8; ++i) { const int kk = kg * 8 + i; *(f32x4*)(dst + kk * 128 + v4) = Sin[i] * D7[kk] + *(const f32x4*)(SF7 + kk * 128 + v4); } }
        if (seg > 0) {
#pragma unroll
            for (int c4 = 0; c4 < 4; ++c4) *(LAS v4u*)(L + (v4 + c4) * LDQ + (kg * 8) * 2) = (v4u){pk2(Sin[0][c4], Sin[1][c4]), pk2(Sin[2][c4], Sin[3][c4]), pk2(Sin[4][c4], Sin[5][c4]), pk2(Sin[6][c4], Sin[7][c4])}; }
        __syncthreads();
#pragma unroll 1
        for (int u2 = 0; u2 < 2; ++u2) { const int idx = 2 * w + u2, row = row_base + (idx >> 2) * 64 + 16 * (idx & 3) + li;
            const bf16* prow = PB + (size_t)row * 2560 + h * 128;
            f32x4 o[8]; v2u gpre[8];
#pragma unroll
            for (int vt = 0; vt < 8; ++vt) gpre[vt] = *(const v2u*)(prow + 1536 + 16 * vt + 4 * lq);
#pragma unroll
            for (int vt = 0; vt < 8; ++vt) { const v2u raw = *(const v2u*)(prow + 1024 + 16 * vt + 4 * lq); o[vt] = (f32x4){pg8::bf_lo(raw.x), pg8::bf_hi(raw.x), pg8::bf_lo(raw.y), pg8::bf_hi(raw.y)}; }
            if (seg > 0) { bf16x8 qf[4];
#pragma unroll
                for (int ks = 0; ks < 4; ++ks) qf[ks] = *(const bf16x8*)(prow + 32 * ks + 8 * lq);
#pragma unroll
                for (int vt = 0; vt < 8; ++vt)
#pragma unroll
                    for (int ks = 0; ks < 4; ++ks) o[vt] = mfma16(*(const LAS bf16x8*)(L + (16 * vt + li) * LDQ + (32 * ks + 8 * lq) * 2), qf[ks], o[vt]); }
            float ss = 0.f;
#pragma unroll
            for (int vt = 0; vt < 8; ++vt) ss += (o[vt][0] * o[vt][0] + o[vt][1] * o[vt][1]) + (o[vt][2] * o[vt][2] + o[vt][3] * o[vt][3]);
            ss += __shfl_xor(ss, 16); ss += __shfl_xor(ss, 32);
            const float sc = rsqrtf(ss * (1.f / DV) + RMS_EPS);
#pragma unroll
            for (int vt = 0; vt < 8; ++vt) { const int v = 16 * vt + 4 * lq; const f32x4 gn = *(const f32x4*)(gw + v); const v2u graw = gpre[vt];
                const f32x4 g = {pg8::bf_lo(graw.x), pg8::bf_hi(graw.x), pg8::bf_lo(graw.y), pg8::bf_hi(graw.y)}; const f32x4 r = o[vt] * sc * gn * g;
                *(v2u*)(A2 + (size_t)row * D + h * 128 + v) = (v2u){pk2(r[0], r[1]), pk2(r[2], r[3])}; } }
        __syncthreads();
    }
}
__device__ __forceinline__ float wave_dpp_add(float v, int ctrl_sel) {
    const int x = __float_as_int(v);
    int y;
    if (ctrl_sel == 0) y = __builtin_amdgcn_update_dpp(0, x, 0xB1, 0xF, 0xF, true);
    else if (ctrl_sel == 1) y = __builtin_amdgcn_update_dpp(0, x, 0x4E, 0xF, 0xF, true);
    else if (ctrl_sel == 2) y = __builtin_amdgcn_update_dpp(0, x, 0x141, 0xF, 0xF, true);
    else y = __builtin_amdgcn_update_dpp(0, x, 0x140, 0xF, 0xF, true);
    return v + __int_as_float(y);
}
__device__ __forceinline__ float wave_sum64(float v) {
    v = wave_dpp_add(v, 0); v = wave_dpp_add(v, 1); v = wave_dpp_add(v, 2); v = wave_dpp_add(v, 3);
    const int x = __float_as_int(v);
    return (__int_as_float(__builtin_amdgcn_readlane(x, 0)) + __int_as_float(__builtin_amdgcn_readlane(x, 16))) + (__int_as_float(__builtin_amdgcn_readlane(x, 32)) + __int_as_float(__builtin_amdgcn_readlane(x, 48)));
}
__device__ __forceinline__ void conf_phase(const Frame& F, const Args& a, int e, int zo) {
    const bf16* PB = (const bf16*)(a.ws + WS_PH); bf16* A2 = (bf16*)(a.ws + WS_A2);
    const float* dww = a.in[zo + 9] + (size_t)e * CK * CW; const float* dwb = a.in[zo + 10] + e * CW; const float* lnw = a.in[zo + 11] + e * CW; const float* lnb = a.in[zo + 12] + e * CW;
    LAS float* WL = (LAS float*)(F.lds + RING_OFF);
    { f32x4 wv[8];
#pragma unroll
      for (int q = 0; q < 8; ++q) { const int i = F.tid + q * NWAVES * 64; wv[q] = (i < CK * CW / 4) ? ((const f32x4*)dww)[i] : (f32x4){0.f, 0.f, 0.f, 0.f}; }
#pragma unroll
      for (int q = 0; q < 8; ++q) { const int i = F.tid + q * NWAVES * 64; ((LAS f32x4*)WL)[i] = wv[q]; } }
    __syncthreads();
    const int gw = F.vcu * NWAVES + F.wave, NGW = F.G * NWAVES, ch = 8 * F.lane;
    LAS unsigned char* US = F.lds + RING_OFF + (CK + 1) * CW * 4;
    for (int blk = F.vcu; blk < MP / 64; blk += F.G) {
        const int wrow0 = blk * 64, wt0 = wrow0 & (SEQ - 1), row0 = wrow0 + 8 * F.wave;
        f32x4 res[2][8];
#pragma unroll
        for (int ps = 0; ps < 2; ++ps) {
            const int c4 = 256 * ps + 4 * F.lane;
            __syncthreads();
            { v4u xx[6];
#pragma unroll
              for (int q = 0; q < 6; ++q) { const int idx = F.tid + q * NWAVES * 64, r = idx >> 5, c16 = idx & 31; int rr = wrow0 - 30 + r; rr = rr < wrow0 - wt0 ? wrow0 - wt0 : (rr > wrow0 + 63 ? wrow0 + 63 : rr);
                  xx[q] = *(const v4u*)(PB + (size_t)rr * 2560 + 2048 + 256 * ps + 8 * c16); }
#pragma unroll
              for (int q = 0; q < 6; ++q) { const int idx = F.tid + q * NWAVES * 64, r = idx >> 5, c16 = idx & 31; const bool ok = (r < 94) && (wt0 - 30 + r >= 0);
                  *(LAS v4u*)(US + r * 512 + 16 * c16) = ok ? xx[q] : (v4u){0u, 0u, 0u, 0u}; } }
            __syncthreads();
            f32x4 acc[8], sl[8];
#pragma unroll
            for (int i = 0; i < 8; ++i) { acc[i] = (f32x4){0.f, 0.f, 0.f, 0.f}; sl[i] = (f32x4){0.f, 0.f, 0.f, 0.f}; }
            const LAS unsigned char* up = US + (8 * F.wave) * 512 + 8 * F.lane; const LAS float* wp = WL + c4;
            v2u rwn0 = *(const LAS v2u*)up, rwn1 = *(const LAS v2u*)(up + 512);
            f32x4 wn0 = *(const LAS f32x4*)wp, wn1 = *(const LAS f32x4*)(wp + CW);
#pragma unroll 1
            for (int q = 0; q < 5; ++q) {
#pragma unroll
                for (int p = 0; p < 8; ++p) { const int r = 8 * q + p;
                    const v2u rw = rwn0; sl[p] = wn0; rwn0 = rwn1; wn0 = wn1;
                    { const int r2 = r + 2, ru = r2 < 39 ? r2 : 39, rwt = r2 < CK ? r2 : CK; rwn1 = *(const LAS v2u*)(up + ru * 512); wn1 = *(const LAS f32x4*)(wp + rwt * CW); }
                    const f32x4 uu = {pg8::bf_lo(rw.x), pg8::bf_hi(rw.x), pg8::bf_lo(rw.y), pg8::bf_hi(rw.y)};
#pragma unroll
                    for (int i = 0; i < 8; ++i) acc[i] += sl[(p - i) & 7] * uu; } }
            const f32x4 bb = *(const f32x4*)(dwb + c4);
#pragma unroll
            for (int i = 0; i < 8; ++i) res[ps][i] = acc[i] + bb;
        }
        const f32x4 w0 = *(const f32x4*)(lnw + 4 * F.lane), w1 = *(const f32x4*)(lnw + 256 + 4 * F.lane), c0 = *(const f32x4*)(lnb + 4 * F.lane), c1 = *(const f32x4*)(lnb + 256 + 4 * F.lane);
#pragma unroll
        for (int i = 0; i < 8; ++i) {
            const f32x4 x0 = res[0][i], x1 = res[1][i];
            const float mean = wave_sum64((x0[0] + x0[1]) + (x0[2] + x0[3]) + (x1[0] + x1[1]) + (x1[2] + x1[3])) * (1.f / CW);
            const f32x4 d0 = x0 - mean, d1 = x1 - mean;
            const float var = wave_sum64((d0[0] * d0[0] + d0[1] * d0[1]) + (d0[2] * d0[2] + d0[3] * d0[3]) + (d1[0] * d1[0] + d1[1] * d1[1]) + (d1[2] * d1[2] + d1[3] * d1[3])) * (1.f / CW);
            const float rs = rsqrtf(var + LN_EPS);
            f32x4 y0 = d0 * rs * w0 + c0, y1 = d1 * rs * w1 + c1;
#pragma unroll
            for (int j = 0; j < 4; ++j) { y0[j] = pg8::fsilu(y0[j]); y1[j] = pg8::fsilu(y1[j]); }
            bf16* op = A2 + (size_t)(row0 + i) * D + HW + 4 * F.lane;
            *(v2u*)op = (v2u){pk2(y0[0], y0[1]), pk2(y0[2], y0[3])}; *(v2u*)(op + 256) = (v2u){pk2(y1[0], y1[1]), pk2(y1[2], y1[3])}; }
    }
    __syncthreads();
}
__device__ __forceinline__ void conf_sample_token(const Frame& F, const Args& a, int e, int zo, int bs) {
    const bf16* PB = (const bf16*)(a.ws + WS_PH); bf16* A2 = (bf16*)(a.ws + WS_A2);
    const float* dww = a.in[zo + 9] + (size_t)e * CK * CW; const float* dwb = a.in[zo + 10] + e * CW; const float* lnw = a.in[zo + 11] + e * CW; const float* lnb = a.in[zo + 12] + e * CW;
    const float* cbuf = a.in[zo + 3] + ((size_t)e * DEC + bs) * 30 * CW;
    LAS float* PS = (LAS float*)(F.lds + RING_OFF);
    const int ch = 8 * F.lane;
    f32x4 h0[4], h1[4], w0[4], w1[4];
#pragma unroll
    for (int q = 0; q < 4; ++q) { const int j = F.wave + 8 * q;
        if (j < CK - 1) { h0[q] = *(const f32x4*)(cbuf + (size_t)j * CW + ch); h1[q] = *(const f32x4*)(cbuf + (size_t)j * CW + ch + 4); }
        else if (j == CK - 1) { const v4u raw = *(const v4u*)(PB + (size_t)(MP + bs) * 2560 + 2048 + ch);
            h0[q] = (f32x4){pg8::bf_lo(raw.x), pg8::bf_hi(raw.x), pg8::bf_lo(raw.y), pg8::bf_hi(raw.y)}; h1[q] = (f32x4){pg8::bf_lo(raw.z), pg8::bf_hi(raw.z), pg8::bf_lo(raw.w), pg8::bf_hi(raw.w)}; }
        else { h0[q] = (f32x4){0.f, 0.f, 0.f, 0.f}; h1[q] = h0[q]; }
        const int jw = j < CK ? j : 0; w0[q] = *(const f32x4*)(dww + (size_t)jw * CW + ch); w1[q] = *(const f32x4*)(dww + (size_t)jw * CW + ch + 4); }
    f32x4 p0 = {0.f, 0.f, 0.f, 0.f}, p1 = p0;
#pragma unroll
    for (int q = 0; q < 4; ++q) { p0 += w0[q] * h0[q]; p1 += w1[q] * h1[q]; }
    *(LAS f32x4*)(PS + F.wave * CW + ch) = p0; *(LAS f32x4*)(PS + F.wave * CW + ch + 4) = p1;
    __syncthreads();
    if (F.wave == 0) {
        f32x4 x0 = *(const f32x4*)(dwb + ch), x1 = *(const f32x4*)(dwb + ch + 4);
#pragma unroll
        for (int q = 0; q < 8; ++q) { x0 += *(const LAS f32x4*)(PS + q * CW + ch); x1 += *(const LAS f32x4*)(PS + q * CW + ch + 4); }
        const f32x4 g0 = *(const f32x4*)(lnw + ch), g1 = *(const f32x4*)(lnw + ch + 4), c0 = *(const f32x4*)(lnb + ch), c1 = *(const f32x4*)(lnb + ch + 4);
        const float mean = wave_sum64((x0[0] + x0[1]) + (x0[2] + x0[3]) + (x1[0] + x1[1]) + (x1[2] + x1[3])) * (1.f / CW);
        const f32x4 d0 = x0 - mean, d1 = x1 - mean;
        const float var = wave_sum64((d0[0] * d0[0] + d0[1] * d0[1]) + (d0[2] * d0[2] + d0[3] * d0[3]) + (d1[0] * d1[0] + d1[1] * d1[1]) + (d1[2] * d1[2] + d1[3] * d1[3])) * (1.f / CW);
        const float rs = rsqrtf(var + LN_EPS);
        f32x4 y0 = d0 * rs * g0 + c0, y1 = d1 * rs * g1 + c1;
#pragma unroll
        for (int j = 0; j < 4; ++j) { y0[j] = pg8::fsilu(y0[j]); y1[j] = pg8::fsilu(y1[j]); }
        *(v4u*)(A2 + (size_t)(MP + bs) * D + HW + ch) = (v4u){pk2(y0[0], y0[1]), pk2(y0[2], y0[3]), pk2(y1[0], y1[1]), pk2(y1[2], y1[3])};
    }
    __syncthreads();
}
__device__ __forceinline__ void hgrn_sample_phase(const Frame& F, const Args& a, int e, int zo) {
    const bf16* PB = (const bf16*)(a.ws + WS_PH); bf16* A2 = (bf16*)(a.ws + WS_A2);
    const float* S0all = a.in[zo + 2] + (size_t)e * DEC * NH * DK * DV; const float* gw = a.in[zo + 8] + e * DV;
    float* o_hs = a.out + (size_t)MT * D + (size_t)2 * NB * NH * DK * DV + (size_t)2 * NB * 30 * CW + (size_t)2 * NB * 2 * D + (size_t)e * DEC * NH * DK * DV;
    LAS float* RED = (LAS float*)(F.lds + RING_OFF);
    const int v4 = (F.tid & 31) * 4, kg = F.tid >> 5;
    for (int unit0 = F.vcu; unit0 < DEC * NH; unit0 += 2 * F.G) {
        f32x4 s0v[2][8], vv[2]; float qq[2][8], lf[2][8];
#pragma unroll
        for (int uu = 0; uu < 2; ++uu) { const int unit = unit0 + uu * F.G; if (unit < DEC * NH) { const int bs = unit >> 2, h = unit & 3;
            const bf16* pr = PB + (size_t)(MP + bs) * 2560 + h * 128; const float* S0 = S0all + (size_t)unit * 16384;
            const v2u vraw = *(const v2u*)(pr + 1024 + v4); vv[uu] = (f32x4){pg8::bf_lo(vraw.x), pg8::bf_hi(vraw.x), pg8::bf_lo(vraw.y), pg8::bf_hi(vraw.y)};
            const v4u qraw = *(const v4u*)(pr + kg * 8), lraw = *(const v4u*)(pr + 512 + kg * 8);
            qq[uu][0] = pg8::bf_lo(qraw.x); qq[uu][1] = pg8::bf_hi(qraw.x); qq[uu][2] = pg8::bf_lo(qraw.y); qq[uu][3] = pg8::bf_hi(qraw.y); qq[uu][4] = pg8::bf_lo(qraw.z); qq[uu][5] = pg8::bf_hi(qraw.z); qq[uu][6] = pg8::bf_lo(qraw.w); qq[uu][7] = pg8::bf_hi(qraw.w);
            lf[uu][0] = pg8::bf_lo(lraw.x); lf[uu][1] = pg8::bf_hi(lraw.x); lf[uu][2] = pg8::bf_lo(lraw.y); lf[uu][3] = pg8::bf_hi(lraw.y); lf[uu][4] = pg8::bf_lo(lraw.z); lf[uu][5] = pg8::bf_hi(lraw.z); lf[uu][6] = pg8::bf_lo(lraw.w); lf[uu][7] = pg8::bf_hi(lraw.w);
#pragma unroll
            for (int j = 0; j < 8; ++j) s0v[uu][j] = *(const f32x4*)(S0 + (kg * 8 + j) * 128 + v4); } }
#pragma unroll
        for (int uu = 0; uu < 2; ++uu) { const int unit = unit0 + uu * F.G; if (unit < DEC * NH) { const int bs = unit >> 2, h = unit & 3;
            const bf16* pr = PB + (size_t)(MP + bs) * 2560 + h * 128; float* Sn = o_hs + (size_t)unit * 16384;
            f32x4 part = {0.f, 0.f, 0.f, 0.f};
#pragma unroll
            for (int j = 0; j < 8; ++j) { const float f = __expf(lf[uu][j]); const f32x4 sx = s0v[uu][j] * f + vv[uu] * (1.f - f); *(f32x4*)(Sn + (kg * 8 + j) * 128 + v4) = sx; part += sx * qq[uu][j]; }
            *(LAS f32x4*)(RED + kg * 128 + v4) = part;
            __syncthreads();
            float o = 0.f;
            if (F.tid < 128) {
#pragma unroll
                for (int g = 0; g < 16; ++g) o += RED[g * 128 + F.tid];
                const float ss = wave_sum64(o * o);
                if (F.lane == 0) RED[2048 + F.wave] = ss; }
            __syncthreads();
            if (F.tid < 128) { const float sc = rsqrtf((RED[2048] + RED[2049]) * (1.f / DV) + RMS_EPS);
                A2[(size_t)(MP + bs) * D + h * 128 + F.tid] = (bf16)f2bf(o * sc * gw[F.tid] * b2f(pr[1536 + F.tid])); }
            __syncthreads(); } }
    }
}
__device__ __forceinline__ void sconv_phase(const Frame& F, const Args& a, int e, int zo) {
    const bf16* BGZ = (const bf16*)(a.ws + WS_PH); bf16* A2 = (bf16*)(a.ws + WS_A2);
    const float* cw = a.in[zo + 14] + (size_t)e * 3 * D;
    const int gw = F.vcu * NWAVES + F.wave, NGW = F.G * NWAVES;
    for (int u = gw; u < (MP / 8) * 2; u += NGW) {
        const int half = u & 1, row0 = (u >> 1) * 8, t0 = row0 & (SEQ - 1), ch = half * 512 + 8 * F.lane;
        f32x4 wq[3][2];
#pragma unroll
        for (int j = 0; j < 3; ++j) { wq[j][0] = *(const f32x4*)(cw + j * D + ch); wq[j][1] = *(const f32x4*)(cw + j * D + ch + 4); }
        f32x4 z[10][2];
#pragma unroll
        for (int r = 0; r < 10; ++r) { z[r][0] = (f32x4){0.f, 0.f, 0.f, 0.f}; z[r][1] = z[r][0];
            if (t0 - 2 + r >= 0) { const v4u raw = *(const v4u*)(BGZ + (size_t)(row0 - 2 + r) * 2048 + 1024 + ch);
                z[r][0] = (f32x4){pg8::bf_lo(raw.x), pg8::bf_hi(raw.x), pg8::bf_lo(raw.y), pg8::bf_hi(raw.y)}; z[r][1] = (f32x4){pg8::bf_lo(raw.z), pg8::bf_hi(raw.z), pg8::bf_lo(raw.w), pg8::bf_hi(raw.w)}; } }
        v4u graw[8];
#pragma unroll
        for (int i = 0; i < 8; ++i) graw[i] = *(const v4u*)(BGZ + (size_t)(row0 + i) * 2048 + ch);
#pragma unroll
        for (int i = 0; i < 8; ++i) { const v4u raw = graw[i];
            const f32x4 g0 = {pg8::bf_lo(raw.x), pg8::bf_hi(raw.x), pg8::bf_lo(raw.y), pg8::bf_hi(raw.y)}, g1 = {pg8::bf_lo(raw.z), pg8::bf_hi(raw.z), pg8::bf_lo(raw.w), pg8::bf_hi(raw.w)};
            const f32x4 y0 = g0 * (wq[0][0] * z[i][0] + wq[1][0] * z[i + 1][0] + wq[2][0] * z[i + 2][0]), y1 = g1 * (wq[0][1] * z[i][1] + wq[1][1] * z[i + 1][1] + wq[2][1] * z[i + 2][1]);
            *(v4u*)(A2 + (size_t)(row0 + i) * D + ch) = (v4u){pk2(y0[0], y0[1]), pk2(y0[2], y0[3]), pk2(y1[0], y1[1]), pk2(y1[2], y1[3])}; }
    }
    const float* sbuf = a.in[zo + 4] + (size_t)e * DEC * 2 * D;
    for (int u = gw; u < DEC * 2; u += NGW) { const int half = u & 1, bs = u >> 1, ch = half * 512 + 8 * F.lane, row = MP + bs;
        const v4u zr = *(const v4u*)(BGZ + (size_t)row * 2048 + 1024 + ch), gr = *(const v4u*)(BGZ + (size_t)row * 2048 + ch);
        const f32x4 z0 = {pg8::bf_lo(zr.x), pg8::bf_hi(zr.x), pg8::bf_lo(zr.y), pg8::bf_hi(zr.y)}, z1 = {pg8::bf_lo(zr.z), pg8::bf_hi(zr.z), pg8::bf_lo(zr.w), pg8::bf_hi(zr.w)};
        const f32x4 g0 = {pg8::bf_lo(gr.x), pg8::bf_hi(gr.x), pg8::bf_lo(gr.y), pg8::bf_hi(gr.y)}, g1 = {pg8::bf_lo(gr.z), pg8::bf_hi(gr.z), pg8::bf_lo(gr.w), pg8::bf_hi(gr.w)};
        const float* h0 = sbuf + ((size_t)bs * 2 + 0) * D + ch; const float* h1 = sbuf + ((size_t)bs * 2 + 1) * D + ch;
        const f32x4 y0 = g0 * (*(const f32x4*)(cw + ch) * *(const f32x4*)h0 + *(const f32x4*)(cw + D + ch) * *(const f32x4*)h1 + *(const f32x4*)(cw + 2 * D + ch) * z0);
        const f32x4 y1 = g1 * (*(const f32x4*)(cw + ch + 4) * *(const f32x4*)(h0 + 4) + *(const f32x4*)(cw + D + ch + 4) * *(const f32x4*)(h1 + 4) + *(const f32x4*)(cw + 2 * D + ch + 4) * z1);
        *(v4u*)(A2 + (size_t)row * D + ch) = (v4u){pk2(y0[0], y0[1]), pk2(y0[2], y0[3]), pk2(y1[0], y1[1]), pk2(y1[2], y1[3])}; }
}
__device__ __forceinline__ void p_even_mixer1(const Frame& F0, const Args& a, int e, int zo) {
    const Frame F = phase_frame(F0);
    hgrn_pass1(F, a.ws);
    conf_phase(F, a, e, zo);
}
__device__ __forceinline__ void p_even_mixer2(const Frame& F0, const Args& a, int e, int zo) {
    const Frame F = phase_frame(F0);
    hgrn_pass2(F, a.ws, a.in[zo + 8] + e * DV, a.out + (size_t)MT * D + (size_t)e * NB * NH * DK * DV);
    for (int u = F.vcu; u < 256; u += F.G) if ((u & 7) < 4) conf_sample_token(F, a, e, zo, (u >> 3) * 4 + (u & 7));
    hgrn_sample_phase(F, a, e, zo);
}
__device__ __forceinline__ void p_odd_mixer(const Frame& F0, const Args& a, int e, int zo) {
    const Frame F = phase_frame(F0);
    sconv_phase(F, a, e, zo);
}
__device__ __forceinline__ int bx_now() { int b = (int)blockIdx.x; asm volatile("" : "+s"(b)); return b; }
__device__ __forceinline__ const float* stats_ptr(const unsigned char* ws, int i) { return (const float*)(ws + (i == 0 ? WS_STATS0 : WS_STATS + (size_t)(i - 1) * STATS_BYTES)); }
__global__ void __launch_bounds__(NWAVES * 64, 2) mk_fwd(Args args) {
    extern __shared__ __attribute__((aligned(16))) unsigned char lds[];
    Frame F;
    F.lds = (LAS unsigned char*)lds;
    F.tid = threadIdx.x; F.lane = F.tid & 63; F.wave = __builtin_amdgcn_readfirstlane(F.tid >> 6);
    F.G = gridDim.x; { const int bx = blockIdx.x; F.vcu = (F.G % 8 == 0) ? (bx % 8) * (F.G / 8) + bx / 8 : bx; }
    unsigned char* ws = args.ws;
    gu32* ctl = (gu32*)(ws + WS_CTL);
    for (int u = F.tid; u < (LDS_BYTES - LDSCTL_OFF) / 4; u += NWAVES * 64) ((LAS unsigned*)(F.lds + LDSCTL_OFF))[u] = 0u;
    __syncthreads();
    XcdBarrier bar; bar.bar = (unsigned*)(ctl + CW_BAR) + args.li * XCD_BAR_WORDS; bar.x = 0; bar.st = nullptr;
    bar = xcd_barrier_post((unsigned*)(ctl + CW_BAR) + args.li * XCD_BAR_WORDS, (volatile LAS unsigned*)(F.lds + MISC_OFF) + 8);
#define IN(k) true
#define SEAM(k) do { XcdBarrier _b; _b.bar = (unsigned*)(args.ws + WS_CTL) + CW_BAR; _b.x = xb_xcc_id(); _b.st = (volatile LAS unsigned*)(F.lds + MISC_OFF) + 8; xcd_barrier(_b); } while (0)
    bf16* Za = (bf16*)(ws + WS_ZA); bf16* Zb = (bf16*)(ws + WS_ZB); bf16* A2 = (bf16*)(ws + WS_A2); bf16* PH = (bf16*)(ws + WS_PH);
    float* out = args.out;
    float* o_hp = out + (size_t)MT * D; float* o_cp = o_hp + (size_t)2 * NB * NH * DK * DV; float* o_sp = o_cp + (size_t)2 * NB * 30 * CW;
    float* o_hs = o_sp + (size_t)2 * NB * 2 * D; float* o_cs = o_hs + (size_t)2 * DEC * NH * DK * DV; float* o_ss = o_cs + (size_t)2 * DEC * 30 * CW;

    if (IN(0)) { p0_prologue(F, args); SEAM(0); }
    for (int l = 0; l < 4; ++l) {
        int zo; asm volatile("s_mov_b32 %0, 0" : "=s"(zo));
        const int pb = 1 + 6 * l, e = l >> 1;
        const unsigned char* wl = ws + WS_W + (size_t)l * W_LAYER;
        const float* cv = (const float*)(ws + WS_CVEC) + (size_t)l * CVEC_LAYER;
        if (IN(pb)) {
            pg8::Gemm g{Za, (const bf16*)(wl + W_IN), MP, EIN, D}; pg8::StaticOrder S; S.init(MP, EIN, F.G, bx_now());

            int l_a = l; asm volatile("" : "+s"(l_a));
            pg8::LnIn ln{stats_ptr(ws, 2 * l_a), cv, cv + EIN};
            if ((l & 1) == 0) { pg8::EpiEvenIn E{ln, PH, (const float*)(ws + WS_LBS) + e * HW, o_cp + (size_t)e * NB * 30 * CW, o_cs + (size_t)e * DEC * 30 * CW};
                pg8::gemm_phase<pg8::EpiEvenIn, pg8::StaticOrder, true, true>(F.lds + RING_OFF, g, S, E, F.wave);
                { int Gq = F.G; asm volatile("" : "+s"(Gq)); const int nmu = g.N >> 5, mfirst = (nmu <= Gq / 2 || Gq < 256) ? (Gq - nmu > 0 ? Gq - nmu : 0) : Gq / 2; for (int mu = (int)blockIdx.x - mfirst; mu >= 0 && mu < nmu; mu += Gq - mfirst) pg8::mini_ring(F.lds + RING_OFF, g.A, g.Bt, g.K, E, mu, F.wave);
                  if (l == 0) { const int w2s = (F.G == 256) ? P_IW2 : 0; if (mfirst > 0) { if ((int)blockIdx.x < mfirst) p_convert_tail(F, args, P_IIN, P_ILAYER - w2s, (int)blockIdx.x, mfirst); } else p_convert_tail(F, args, P_IIN, P_ILAYER - w2s, (int)blockIdx.x, F.G); } } }
            else { pg8::EpiOddIn E{ln, PH, o_sp + (size_t)e * NB * 2 * D, o_ss + (size_t)e * DEC * 2 * D};
                pg8::gemm_phase<pg8::EpiOddIn, pg8::StaticOrder, true, true>(F.lds + RING_OFF, g, S, E, F.wave);
                { int Gq = F.G; asm volatile("" : "+s"(Gq)); const int nmu = g.N >> 5, mfirst = (nmu <= Gq / 2 || Gq < 256) ? (Gq - nmu > 0 ? Gq - nmu : 0) : Gq / 2; for (int mu = (int)blockIdx.x - mfirst; mu >= 0 && mu < nmu; mu += Gq - mfirst) pg8::mini_ring(F.lds + RING_OFF, g.A, g.Bt, g.K, E, mu, F.wave); } }
            SEAM(pb);
        }
        if (IN(pb + 1)) { if ((l & 1) == 0) p_even_mixer1(F, args, e, zo); else p_odd_mixer(F, args, e, zo); SEAM(pb + 1); }
        if (IN(pb + 2) && (l & 1) == 0) { p_even_mixer2(F, args, e, zo); SEAM(pb + 2); }
        if (IN(pb + 3)) {
            pg8::Gemm g{A2, (const bf16*)(wl + W_OUT), MP, D, D}; pg8::StaticOrder S; S.init(MP, D, F.G, bx_now());
            int l_b = l; asm volatile("" : "+s"(l_b));
            pg8::EpiRes<false> E{Za, stats_ptr(ws, 2 * l_b), l_b > 0 ? args.in[zo + 21] + (size_t)(l_b - 1) * D : (const float*)(ws + WS_ONES), l_b > 0 ? args.in[zo + 22] + (size_t)(l_b - 1) * D : (const float*)(ws + WS_ZEROS),
                                 Zb, nullptr, (float*)stats_ptr(ws, 2 * l + 1)};
            pg8::gemm_phase<pg8::EpiRes<false>, pg8::StaticOrder, true, true>(F.lds + RING_OFF, g, S, E, F.wave);
            SEAM(pb + 3);
        }
        if (IN(pb + 4)) {
            unsigned* sctr = (unsigned*)(ctl + CW_SCTR) + 64 * l;
            {
                int l_c = l; asm volatile("" : "+s"(l_c));
                pg8::EpiRes<false> Eo{Za, stats_ptr(ws, 2 * l_c), l_c > 0 ? args.in[zo + 21] + (size_t)(l_c - 1) * D : (const float*)(ws + WS_ONES), l_c > 0 ? args.in[zo + 22] + (size_t)(l_c - 1) * D : (const float*)(ws + WS_ZEROS),
                                      Zb, nullptr, (float*)stats_ptr(ws, 2 * l + 1)};
                const int nmo = D >> 5, mfo = F.G > nmo ? F.G - nmo : 0; unsigned ndone = 0u;
                for (int mu = (int)blockIdx.x - mfo; mu >= 0 && mu < nmo; mu += F.G - mfo) { pg8::mini_ring(F.lds + RING_OFF, A2, (const bf16*)(wl + W_OUT), D, Eo, mu, F.wave); ++ndone; }
                if (ndone) sample_publish(F, sctr, ndone);
            }
            pg8::Gemm g{Zb, (const bf16*)(wl + W_13), MP, NUP, D}; pg8::StaticOrder S; S.init(MP, NUP, F.G, bx_now());
            pg8::EpiUp E{pg8::LnIn{stats_ptr(ws, 2 * l + 1), cv + 2 * EIN, cv + 2 * EIN + NUP}, PH};
            pg8::gemm_phase<pg8::EpiUp, pg8::StaticOrder, true, true>(F.lds + RING_OFF, g, S, E, F.wave);
            { int Gq = F.G; asm volatile("" : "+s"(Gq)); const int nmu = g.N >> 5, mfirst = (nmu <= Gq / 2 || Gq < 256) ? (Gq - nmu > 0 ? Gq - nmu : 0) : Gq / 2;
              const int mfo2 = F.G > (D >> 5) ? F.G - (D >> 5) : 0, uhi = (mfo2 > mfirst && 2 * (mfo2 - mfirst) >= nmu) ? mfo2 : F.G;
              if ((int)blockIdx.x >= mfirst && (int)blockIdx.x < uhi) { sample_wait(F, sctr, (unsigned)(D >> 5));
                  for (int mu = (int)blockIdx.x - mfirst; mu >= 0 && mu < nmu; mu += uhi - mfirst) pg8::mini_ring(F.lds + RING_OFF, g.A, g.Bt, g.K, E, mu, F.wave); } }
            if (F.G == 256 && (int)blockIdx.x >= 128) { const int wi = (int)blockIdx.x - 128;
                if (l == 0) p_convert_tail(F, args, P_ILAYER - P_IW2, P_ILAYER, wi, 128);
                if (l < 3) { const int xs = (l == 0) ? 768 : 1792; p_convert_tail(F, args, (l + 2) * P_ILAYER - xs, (l + 2) * P_ILAYER, wi, 128); } }
            SEAM(pb + 4);
        }
        if (IN(pb + 5)) {
            pg8::Gemm g{PH, (const bf16*)(wl + W_2), MP, D, DFF}; pg8::StaticOrder S; S.init(MP, D, F.G, bx_now());

            { pg8::EpiRes<false> E{Zb, stats_ptr(ws, 2 * l + 1), args.in[zo + 19] + (size_t)l * D, args.in[zo + 20] + (size_t)l * D, Za, nullptr, (float*)stats_ptr(ws, 2 * l + 2)};
                pg8::gemm_phase<pg8::EpiRes<false>, pg8::StaticOrder, true, true>(F.lds + RING_OFF, g, S, E, F.wave);
                { int Gq = F.G; asm volatile("" : "+s"(Gq)); const int nmu = g.N >> 5, mfirst = (nmu <= Gq / 2 || Gq < 256) ? (Gq - nmu > 0 ? Gq - nmu : 0) : Gq / 2; for (int mu = (int)blockIdx.x - mfirst; mu >= 0 && mu < nmu; mu += Gq - mfirst) pg8::mini_ring(F.lds + RING_OFF, g.A, g.Bt, g.K, E, mu, F.wave);
                  if (l < 3) { if (mfirst > 0) { if ((int)blockIdx.x < mfirst) { p_convert_tail(F, args, (l + 1) * P_ILAYER, (l + 2) * P_ILAYER - ((F.G == 256) ? (l == 0 ? 768 : 1792) : 0), (int)blockIdx.x, mfirst); if (l == 0) p_state_copies_tail(F, args, (int)blockIdx.x, mfirst); } }
                  else { p_convert_tail(F, args, (l + 1) * P_ILAYER, (l + 2) * P_ILAYER - ((F.G == 256) ? (l == 0 ? 768 : 1792) : 0), (int)blockIdx.x, F.G); if (l == 0) p_state_copies_tail(F, args, (int)blockIdx.x, F.G); } } } }
            SEAM(pb + 5);
        }
    }
    if (IN(25)) p_final_ln(F, args);
#undef IN
#undef SEAM
}
extern "C" void kernel_launch(void* const* d_in, const int* in_sizes, int n_in, void* d_out, int out_size, void* d_ws, size_t ws_size, hipStream_t stream) {
    static int grid = 0;
    if (grid == 0) {
        if (n_in != 23 || ws_size < WS_END) { fprintf(stderr, "kernel_launch: built for 23 inputs and >= %zu bytes of workspace; got n_in %d, ws %zu; nothing launched\n", (size_t)WS_END, n_in, ws_size); grid = -1; return; }
        int dev = 0, cus = 0;
        if (hipGetDevice(&dev) != hipSuccess || hipDeviceGetAttribute(&cus, hipDeviceAttributeMultiprocessorCount, dev) != hipSuccess) { grid = -1; return; }
        if (hipFuncSetAttribute((const void*)mk_fwd, hipFuncAttributeMaxDynamicSharedMemorySize, LDS_BYTES) != hipSuccess) { fprintf(stderr, "kernel_launch: hipFuncSetAttribute failed\n"); grid = -1; return; }
        grid = cus;
    }
    if (grid < 0) return;
    hipMemsetAsync((char*)d_ws + WS_CTL, 0, CTL_ZERO_BYTES, stream);
    Args a{};
    for (int i = 0; i < 23; ++i) a.in[i] = (const float*)d_in[i];
    a.out = (float*)d_out; a.ws = (unsigned char*)d_ws;
    int li = 0;
    auto run = [&](int lo, int hi) { a.ph_lo = lo; a.ph_hi = hi; a.li = li++; hipLaunchKernelGGL(mk_fwd, dim3(grid), dim3(NWAVES * 64), LDS_BYTES, stream, a); };
    run(0, 26);
}
```

```cpp
#include <hip/hip_runtime.h>
#include <cstdio>
#include <cstdint>
__device__ __forceinline__ int lane_id_now() { int l; asm volatile("v_mbcnt_lo_u32_b32 %0, -1, 0\n\tv_mbcnt_hi_u32_b32 %0, -1, %0" : "=v"(l)); return l; }
namespace pg8 {
#define PG8_LAS __attribute__((address_space(3)))
typedef unsigned short bf16_t;
typedef short bf16x8 __attribute__((ext_vector_type(8)));
typedef float f32x4 __attribute__((ext_vector_type(4)));
typedef unsigned u32x4 __attribute__((ext_vector_type(4)));
constexpr int BM = 256, BK = 64, HALF = 128, HTB = HALF * BK * 2  , STAGE_BYTES = 8 * HTB, NXCD = 8, WGM = 8;

__host__ __device__ __forceinline__ int lds_byte(int r, int c) { const int st = (r >> 4) * 2 + (c >> 5), rr = r & 15, cc = c & 31, ob = rr * 64 + cc * 2; return st * 1024 + (ob ^ (((ob >> 9) & 1) << 5)); }
__host__ __device__ __forceinline__ void stage_rc(int b, int& R, int& C) { const int st = b / 1024, sb = b % 1024, swz = sb ^ (((sb >> 9) & 1) << 5); R = (st >> 1) * 16 + swz / 64; C = (st & 1) * 32 + (swz % 64) / 2; }
__host__ __device__ __forceinline__ int perm32(int rho) { const int n = rho >> 4, i = rho & 15; return 8 * (i >> 2) + 4 * n + (i & 3); }

struct Unit { int pm, pn; };
struct Gemm { const bf16_t* A; const bf16_t* Bt; int M, N, K; };

struct StaticOrder {
    int nM, nN, nwg, G, c;
    __host__ __device__ void init(int M, int N, int G_, int c_) { nM = M / BM; nN = N / BM; nwg = nM * nN; G = G_; c = c_; }
    __host__ __device__ bool next(int i, Unit& u) const {
        const long L = (long)i * G + c; if (L >= nwg) return false;
        int wgid = (int)L; { const int q = nwg / NXCD, r = nwg % NXCD, xcd = wgid % NXCD, off = wgid / NXCD; wgid = (xcd < r ? xcd * (q + 1) : r * (q + 1) + (xcd - r) * q) + off; }
        const int nig = WGM * nN, gid = wgid / nig, fm = gid * WGM, gsz = (nM - fm) < WGM ? (nM - fm) : WGM;
        u.pm = fm + ((wgid % nig) % gsz); u.pn = (wgid % nig) / gsz; return true;
    }
    __device__ __forceinline__ void a_ready(const Unit&) const {}
    __device__ __forceinline__ void done(const Unit&) const {}
};

__device__ __forceinline__ unsigned cvt_pk_bf16(float lo, float hi) { unsigned r; asm volatile("v_cvt_pk_bf16_f32 %0, %1, %2" : "=v"(r) : "v"(lo), "v"(hi)); return r; }
typedef float f32x2 __attribute__((ext_vector_type(2)));
#define EPI_RETIRE() __builtin_amdgcn_s_waitcnt(0x0F70)
constexpr int MP_ = 16384, NSMP_ = 128;
constexpr float LN_EPS_ = 1e-5f, ALPHA_ = 1.6817928305074292f;
__device__ __forceinline__ float bf_lo(unsigned w) { return __uint_as_float(w << 16); }
__device__ __forceinline__ float bf_hi(unsigned w) { return __uint_as_float(w & 0xffff0000u); }
__device__ __forceinline__ float fsig(float x) { return __builtin_amdgcn_rcpf(1.f + __expf(-x)); }
__device__ __forceinline__ float fsilu(float x) { return x * fsig(x); }
__device__ __forceinline__ f32x4 vsig(const f32x4& x) { const f32x4 t = x * -1.4426950408889634f; f32x4 e;
#pragma unroll
    for (int j = 0; j < 4; ++j) e[j] = __builtin_amdgcn_exp2f(t[j]);
    e = e + 1.f; f32x4 r;
#pragma unroll
    for (int j = 0; j < 4; ++j) r[j] = __builtin_amdgcn_rcpf(e[j]);
    return r; }
__device__ __forceinline__ f32x4 vsilu(const f32x4& x) { return x * vsig(x); }
__device__ __forceinline__ f32x4 vlogf_gate(const f32x4& lb, const f32x4& x) { const f32x4 y = (1.f - lb) * vsig(x) + lb; f32x4 r;
#pragma unroll
    for (int j = 0; j < 4; ++j) r[j] = fmaxf(__builtin_amdgcn_logf(y[j]) * 0.6931471805599453f, -60.f);
    return r; }
struct LnIn { const float* stats; const float* c1; const float* c2; };
__device__ __forceinline__ void ln_row(const float* stats, int row, float& rA, float& rB) {
    const f32x2 s = *(const f32x2*)(stats + 2 * (size_t)row);
    const float mu = s.x * (1.f / 1024.f), var = fmaxf(s.y * (1.f / 1024.f) - mu * mu, 0.f);
    rA = __builtin_amdgcn_rsqf(var + LN_EPS_); rB = -rA * mu;
}
constexpr int EPV_OFF = 132096, EPV_BYTES = 4096;
__device__ __forceinline__ void glds4_asm(const void* gsrc, unsigned lds_dst) { unsigned keep;
    asm volatile("s_mov_b32 %0, m0\n\ts_mov_b32 m0, %2\n\ts_nop 0\n\tglobal_load_lds_dword %1, off\n\ts_mov_b32 m0, %0" : "=&s"(keep) : "v"(gsrc), "s"(lds_dst) : "memory"); }
template <class Epi> __device__ __forceinline__ void epi_prefetch(const Epi& E, int pm, int pn, unsigned ev_wave, int tid) {
    glds4_asm(E.pf_stats() + (size_t)pm * 512 + tid, ev_wave);
    glds4_asm((tid < 256 ? E.pf_c1() : E.pf_c2() - 256) + pn * 256 + tid, ev_wave + 2048u);
}
__device__ __forceinline__ void ln_row_lds(const PG8_LAS unsigned char* ev, int rl, float& rA, float& rB) {
    const f32x2 s = *(const PG8_LAS f32x2*)(ev + rl * 8);
    const float mu = s.x * (1.f / 1024.f), var = fmaxf(s.y * (1.f / 1024.f) - mu * mu, 0.f);
    rA = __builtin_amdgcn_rsqf(var + LN_EPS_); rB = -rA * mu;
}
#define EPV_K(dst1, dst2) do { _Pragma("unroll") for (int bj = 0; bj < 2; ++bj) _Pragma("unroll") for (int n = 0; n < 2; ++n) { \
        dst1[bj][n] = *(const PG8_LAS f32x4*)(ev + 2048 + (wc * 32 + 8 * fq + bj * HALF + 4 * n) * 4); dst2[bj][n] = *(const PG8_LAS f32x4*)(ev + 3072 + (wc * 32 + 8 * fq + bj * HALF + 4 * n) * 4); } } while (0)
__device__ __forceinline__ void ln_rows8(const float* stats, int row0, float (&rA)[8], float (&rB)[8]) {
    f32x2 sv[8];
#pragma unroll
    for (int q = 0; q < 8; ++q) sv[q] = *(const f32x2*)(stats + 2 * (size_t)(row0 + (q >> 2) * HALF + (q & 3) * 16));
#pragma unroll
    for (int q = 0; q < 8; ++q) { const float mu = sv[q].x * (1.f / 1024.f), var = fmaxf(sv[q].y * (1.f / 1024.f) - mu * mu, 0.f); rA[q] = __builtin_amdgcn_rsqf(var + LN_EPS_); rB[q] = -rA[q] * mu; }
}
__device__ __forceinline__ void ln_rows4(const float* stats, int rowh, float (&rA)[4], float (&rB)[4]) {
    f32x2 sv[4];
#pragma unroll
    for (int q = 0; q < 4; ++q) sv[q] = *(const f32x2*)(stats + 2 * (size_t)(rowh + q * 16));
#pragma unroll
    for (int q = 0; q < 4; ++q) { const float mu = sv[q].x * (1.f / 1024.f), var = fmaxf(sv[q].y * (1.f / 1024.f) - mu * mu, 0.f); rA[q] = __builtin_amdgcn_rsqf(var + LN_EPS_); rB[q] = -rA[q] * mu; }
}
__device__ __forceinline__ void st16_wt_e(void* p, u32x4 v) { asm volatile("global_store_dwordx4 %0, %1, off sc1\n\ts_nop 1" :: "v"(p), "v"(v) : "memory"); }
__device__ __forceinline__ void st16_sel(void* p, u32x4 v, bool wt) { if (wt) st16_wt_e(p, v); else *(u32x4*)p = v; }
__device__ __forceinline__ u32x4 pack8(const f32x4& v0, const f32x4& v1) { u32x4 w; w.x = cvt_pk_bf16(v0[0], v0[1]); w.y = cvt_pk_bf16(v0[2], v0[3]); w.z = cvt_pk_bf16(v1[0], v1[1]); w.w = cvt_pk_bf16(v1[2], v1[3]); return w; }

struct EpiEvenIn {
    static constexpr bool PERM = true, AFTER_DRAIN = false;
    __device__ __forceinline__ const float* pf_stats() const { return ln.stats; } __device__ __forceinline__ const float* pf_c1() const { return ln.c1; } __device__ __forceinline__ const float* pf_c2() const { return ln.c2; }
    LnIn ln; bf16_t* PB; const float* lb; float* newc_p; float* newc_s;
    __device__ __forceinline__ void operator()(const f32x4 (&acc)[2][2][4][2], const Unit& u, int wr, int wc, int fr, int fq, int rowmask, const PG8_LAS unsigned char* ev) const {
        const int pn = u.pn, row0 = u.pm * BM + wr * 64 + fr, gcol0 = pn * BM + wc * 32 + 8 * fq;
        f32x4 k1[2][2], k2[2][2]; EPV_K(k1, k2);
        const int rl0 = wr * 64 + fr;
        if (pn < 8) {
            const int type = pn >> 1;
#define EVEN_ROWS(FN) do { _Pragma("unroll") for (int ai = 0; ai < 2; ++ai) { \
                _Pragma("unroll") for (int m = 0; m < 4; ++m) { if (!((rowmask >> (ai * 4 + m)) & 1)) continue; const int row = row0 + ai * HALF + m * 16; float rA, rB; ln_row_lds(ev, rl0 + ai * HALF + m * 16, rA, rB); \
                    bf16_t* rowp = PB + (size_t)row * 2560 + gcol0; \
                    _Pragma("unroll") for (int bj = 0; bj < 2; ++bj) { f32x4 v[2]; \
                        _Pragma("unroll") for (int n = 0; n < 2; ++n) { const f32x4 xv = acc[ai][bj][m][n] * rA + (k1[bj][n] * rB + k2[bj][n]); v[n] = FN; } \
                        st16_sel(rowp + bj * HALF, pack8(v[0], v[1]), (rowmask & 0x200) != 0); } } } } while (0)
            if (type == 0) EVEN_ROWS(vsilu(xv) * 0.08838834764831845f);
            else if (type == 1) { f32x4 lbv[2][2];
#pragma unroll
                for (int bj = 0; bj < 2; ++bj)
#pragma unroll
                    for (int n = 0; n < 2; ++n) lbv[bj][n] = *(const f32x4*)(lb + (gcol0 - 512) + bj * HALF + 4 * n);
                EVEN_ROWS(vlogf_gate(lbv[bj][n], xv)); }
            else if (type == 2) EVEN_ROWS(xv);
            else EVEN_ROWS(vsilu(xv));
#undef EVEN_ROWS
        } else {
            const int oc = (pn - 8) * 128 + wc * 32 + 8 * fq;
#pragma unroll
            for (int ai = 0; ai < 2; ++ai) {
#pragma unroll
                for (int m = 0; m < 4; ++m) { if (!((rowmask >> (ai * 4 + m)) & 1)) continue; const int row = row0 + ai * HALF + m * 16; float rA, rB; ln_row_lds(ev, wr * 64 + fr + ai * HALF + m * 16, rA, rB);
                    f32x4 v[2];
#pragma unroll
                    for (int n = 0; n < 2; ++n) { const f32x4 a = acc[ai][0][m][n] * rA + (k1[0][n] * rB + k2[0][n]), g = acc[ai][1][m][n] * rA + (k1[1][n] * rB + k2[1][n]);
                        v[n] = a * vsig(g); }
                    st16_sel(PB + (size_t)row * 2560 + 2048 + oc, pack8(v[0], v[1]), (rowmask & 0x200) != 0);
                    if (row < MP_) { const int t = row & 2047; if (t >= 2018) { float* p = newc_p + ((size_t)(row >> 11) * 30 + (t - 2018)) * 512 + oc; *(f32x4*)p = v[0]; *(f32x4*)(p + 4) = v[1]; } }
                    else if (row < MP_ + NSMP_) { float* p = newc_s + ((size_t)(row - MP_) * 30 + 29) * 512 + oc; *(f32x4*)p = v[0]; *(f32x4*)(p + 4) = v[1]; } } }
        }
    }
};
struct EpiOddIn {
    static constexpr bool PERM = true, AFTER_DRAIN = false;
    __device__ __forceinline__ const float* pf_stats() const { return ln.stats; } __device__ __forceinline__ const float* pf_c1() const { return ln.c1; } __device__ __forceinline__ const float* pf_c2() const { return ln.c2; }
    LnIn ln; bf16_t* BGZ; float* news_p; float* news_s;
    __device__ __forceinline__ void operator()(const f32x4 (&acc)[2][2][4][2], const Unit& u, int wr, int wc, int fr, int fq, int rowmask, const PG8_LAS unsigned char* ev) const {
        const int pn = u.pn, row0 = u.pm * BM + wr * 64 + fr, gcol0 = pn * BM + wc * 32 + 8 * fq;
        f32x4 k1[2][2], k2[2][2]; EPV_K(k1, k2);
        const int rl0 = wr * 64 + fr;
        if (pn < 4) {
#pragma unroll
            for (int ai = 0; ai < 2; ++ai) {
#pragma unroll
                for (int m = 0; m < 4; ++m) { if (!((rowmask >> (ai * 4 + m)) & 1)) continue; const int row = row0 + ai * HALF + m * 16; float rA, rB; ln_row_lds(ev, wr * 64 + fr + ai * HALF + m * 16, rA, rB);
                    bf16_t* rowp = BGZ + (size_t)row * 2048 + gcol0;
#pragma unroll
                    for (int bj = 0; bj < 2; ++bj) { const f32x4 v0 = acc[ai][bj][m][0] * rA + (k1[bj][0] * rB + k2[bj][0]), v1 = acc[ai][bj][m][1] * rA + (k1[bj][1] * rB + k2[bj][1]);
                        st16_sel(rowp + bj * HALF, pack8(v0, v1), (rowmask & 0x200) != 0); } } }
        } else {
            const int oc = (pn - 4) * 128 + wc * 32 + 8 * fq;
#pragma unroll
            for (int ai = 0; ai < 2; ++ai) {
#pragma unroll
                for (int m = 0; m < 4; ++m) { if (!((rowmask >> (ai * 4 + m)) & 1)) continue; const int row = row0 + ai * HALF + m * 16; float rA, rB; ln_row_lds(ev, wr * 64 + fr + ai * HALF + m * 16, rA, rB);
                    f32x4 v[2];
#pragma unroll
                    for (int n = 0; n < 2; ++n) { const f32x4 a = acc[ai][0][m][n] * rA + (k1[0][n] * rB + k2[0][n]), g = acc[ai][1][m][n] * rA + (k1[1][n] * rB + k2[1][n]); v[n] = a * g; }
                    st16_sel(BGZ + (size_t)row * 2048 + 1024 + oc, pack8(v[0], v[1]), (rowmask & 0x200) != 0);
                    if (row < MP_) { const int t = row & 2047; if (t >= 2046) { float* p = news_p + ((size_t)(row >> 11) * 2 + (t - 2046)) * 1024 + oc; *(f32x4*)p = v[0]; *(f32x4*)(p + 4) = v[1]; } }
                    else if (row < MP_ + NSMP_) { float* p = news_s + ((size_t)(row - MP_) * 2 + 1) * 1024 + oc; *(f32x4*)p = v[0]; *(f32x4*)(p + 4) = v[1]; } } }
        }
    }
};
struct EpiUp {
    static constexpr bool PERM = true, AFTER_DRAIN = false;
    __device__ __forceinline__ const float* pf_stats() const { return ln.stats; } __device__ __forceinline__ const float* pf_c1() const { return ln.c1; } __device__ __forceinline__ const float* pf_c2() const { return ln.c2; }
    LnIn ln; bf16_t* H;
    __device__ __forceinline__ void operator()(const f32x4 (&acc)[2][2][4][2], const Unit& u, int wr, int wc, int fr, int fq, int rowmask, const PG8_LAS unsigned char* ev) const {
        const int pn = u.pn, row0 = u.pm * BM + wr * 64 + fr, gcol0 = pn * BM + wc * 32 + 8 * fq, oc = pn * 128 + wc * 32 + 8 * fq;
        f32x4 k1[2][2], k2[2][2]; EPV_K(k1, k2);
        const int rl0 = wr * 64 + fr;
#pragma unroll
        for (int ai = 0; ai < 2; ++ai)
#pragma unroll
            for (int m = 0; m < 4; ++m) { if (!((rowmask >> (ai * 4 + m)) & 1)) continue; const int row = row0 + ai * HALF + m * 16; float rA, rB; ln_row_lds(ev, rl0 + ai * HALF + m * 16, rA, rB);
                f32x4 v[2];
#pragma unroll
                for (int n = 0; n < 2; ++n) { const f32x4 a = acc[ai][0][m][n] * rA + (k1[0][n] * rB + k2[0][n]), g = acc[ai][1][m][n] * rA + (k1[1][n] * rB + k2[1][n]);
                    v[n] = vsilu(a) * g; }
                st16_sel(H + (size_t)row * 2816 + oc, pack8(v[0], v[1]), (rowmask & 0x200) != 0); }
    }
};
template <bool F32OUT> struct EpiRes {
    static constexpr bool PERM = true, AFTER_DRAIN = false;
    __device__ __forceinline__ const float* pf_stats() const { return stats_res; } __device__ __forceinline__ const float* pf_c1() const { return w_res; } __device__ __forceinline__ const float* pf_c2() const { return b_res; }
    const bf16_t* Zres; const float* stats_res; const float* w_res; const float* b_res; bf16_t* Zout; float* Fout; float* stats_out;
    __device__ __forceinline__ void operator()(const f32x4 (&acc)[2][2][4][2], const Unit& u, int wr, int wc, int fr, int fq, int rowmask, const PG8_LAS unsigned char* ev) const {
        const int row0 = u.pm * BM + wr * 64 + fr, gcol0 = u.pn * BM + wc * 32 + 8 * fq;
        const unsigned zoff0 = (unsigned)(row0 * 1024 + gcol0) * 2u;
        u32x4 zpre[2][4][2];
#pragma unroll
        for (int ai = 0; ai < 2; ++ai)
#pragma unroll
            for (int m = 0; m < 4; ++m)
#pragma unroll
                for (int bj = 0; bj < 2; ++bj) zpre[ai][m][bj] = ((rowmask >> (ai * 4 + m)) & 1) ? *(const u32x4*)((const char*)Zres + (zoff0 + (unsigned)((ai * HALF + m * 16) * 2048 + bj * HALF * 2))) : (u32x4){0u, 0u, 0u, 0u};
#pragma unroll
        for (int ai = 0; ai < 2; ++ai) {
#pragma unroll
            for (int m = 0; m < 4; ++m) { if (!((rowmask >> (ai * 4 + m)) & 1)) continue; const int row = row0 + ai * HALF + m * 16; float rA, rB; ln_row_lds(ev, wr * 64 + fr + ai * HALF + m * 16, rA, rB);
                float s = 0.f, q = 0.f;
#pragma unroll
                for (int bj = 0; bj < 2; ++bj) { const u32x4 zr = zpre[ai][m][bj];
                    f32x4 x0 = {bf_lo(zr.x), bf_hi(zr.x), bf_lo(zr.y), bf_hi(zr.y)}, x1 = {bf_lo(zr.z), bf_hi(zr.z), bf_lo(zr.w), bf_hi(zr.w)};
                    const PG8_LAS f32x4* kp = (const PG8_LAS f32x4*)(ev + 2048 + (wc * 32 + 8 * fq + bj * HALF) * 4);
                    f32x4 z0 = ((x0 * rA + rB) * kp[0] + kp[64]) * ALPHA_ + acc[ai][bj][m][0], z1 = ((x1 * rA + rB) * kp[1] + kp[65]) * ALPHA_ + acc[ai][bj][m][1];
                    if (F32OUT) { if (row < MP_ + NSMP_) { float* p = Fout + (size_t)row * 1024 + gcol0 + bj * HALF; *(f32x4*)p = z0; *(f32x4*)(p + 4) = z1; } }
                    else { const u32x4 w = pack8(z0, z1); st16_sel(Zout + (size_t)row * 1024 + gcol0 + bj * HALF, w, (rowmask & 0x200) != 0);
                        z0 = (f32x4){bf_lo(w.x), bf_hi(w.x), bf_lo(w.y), bf_hi(w.y)}; z1 = (f32x4){bf_lo(w.z), bf_hi(w.z), bf_lo(w.w), bf_hi(w.w)}; }
                    s += (z0[0] + z0[1]) + (z0[2] + z0[3]) + (z1[0] + z1[1]) + (z1[2] + z1[3]);
                    q += (z0[0] * z0[0] + z0[1] * z0[1]) + (z0[2] * z0[2] + z0[3] * z0[3]) + (z1[0] * z1[0] + z1[1] * z1[1]) + (z1[2] * z1[2] + z1[3] * z1[3]); }
                s += __shfl_xor(s, 16); s += __shfl_xor(s, 32); q += __shfl_xor(q, 16); q += __shfl_xor(q, 32);
                if (fq == 0) { atomicAdd(stats_out + 2 * (size_t)row, s); atomicAdd(stats_out + 2 * (size_t)row + 1, q); } } }
        EPI_RETIRE();
    }
};

template <class Epi, int RT = 4>
__device__ __forceinline__ void mini_gemm(PG8_LAS unsigned char* lds, const bf16_t* A, const bf16_t* Bt, int K, const Epi& E, int mu, int wave_u) {
    int tid_ = wave_u * 64 + lane_id_now(); asm volatile("" : "+v"(tid_));
    const int tid = tid_, w = __builtin_amdgcn_readfirstlane(tid >> 6), lane = tid & 63, li = lane & 15, lq = lane >> 4;
    constexpr int RB = RT == 4 ? 1 : 2, NT = RT * 4;
    const int rsel = mu & ((1 << RB) - 1), wc = (mu >> RB) & 3, j = mu >> (RB + 2);
    const int kslice = K >> 3, nks = kslice >> 5;
    epi_prefetch(E, MP_ / BM, j, (unsigned)__builtin_amdgcn_readfirstlane((int)((unsigned)(size_t)lds + (unsigned)EPV_OFF + (unsigned)w * 256u)), tid);
    const bf16_t* ap = A + (size_t)(MP_ + 16 * RT * rsel + li) * K + w * kslice + 8 * lq;
    const bf16_t* bp = Bt + (size_t)(256 * j + 32 * wc + li) * K + w * kslice + 8 * lq;
    f32x4 acc[RT][4];
#pragma unroll
    for (int a = 0; a < RT; ++a)
#pragma unroll
        for (int b = 0; b < 4; ++b) acc[a][b] = (f32x4){0.f, 0.f, 0.f, 0.f};
#pragma unroll 1
    for (int ks0 = 0; ks0 < nks; ks0 += 4) {
        bf16x8 af[4][RT], bfr[4][4];
#pragma unroll
        for (int i = 0; i < 4; ++i) if (ks0 + i < nks) {
#pragma unroll
            for (int x = 0; x < 4; ++x) { if (x < RT) af[i][x] = *(const bf16x8*)(ap + (size_t)(16 * x) * K + 32 * (ks0 + i)); bfr[i][x] = *(const bf16x8*)(bp + (size_t)(128 * (x >> 1) + 16 * (x & 1)) * K + 32 * (ks0 + i)); } }
#pragma unroll
        for (int i = 0; i < 4; ++i) if (ks0 + i < nks) {
#pragma unroll
            for (int mt = 0; mt < RT; ++mt)
#pragma unroll
                for (int nt = 0; nt < 4; ++nt) acc[mt][nt] = __builtin_amdgcn_mfma_f32_16x16x32_bf16(bfr[i][nt], af[i][mt], acc[mt][nt], 0, 0, 0); }
    }
    PG8_LAS f32x4* PART = (PG8_LAS f32x4*)lds;
#pragma unroll
    for (int mt = 0; mt < RT; ++mt)
#pragma unroll
        for (int nt = 0; nt < 4; ++nt) PART[(w * NT + 4 * mt + nt) * 64 + lane] = acc[mt][nt];
    asm volatile("s_waitcnt vmcnt(0) lgkmcnt(0)" ::: "memory"); __builtin_amdgcn_s_barrier(); asm volatile("" ::: "memory");
    {
#pragma unroll
        for (int x = 0; x < NT / 8; ++x) { const int tl = (NT / 8) * w + x; f32x4 s0 = PART[tl * 64 + lane];
#pragma unroll
            for (int q = 1; q < 8; ++q) s0 += PART[(q * NT + tl) * 64 + lane];
            PART[tl * 64 + lane] = s0; } }
    asm volatile("s_waitcnt lgkmcnt(0)" ::: "memory"); __builtin_amdgcn_s_barrier(); asm volatile("" ::: "memory");
    if (w < RT) {
        const int fr = li, fq = lq;
        f32x4 big[2][2][4][2];
#pragma unroll
        for (int m = 0; m < 4; ++m)
#pragma unroll
            for (int bj = 0; bj < 2; ++bj)
#pragma unroll
                for (int n = 0; n < 2; ++n) { big[0][bj][m][n] = m < RT ? PART[(4 * m + 2 * bj + (fq >> 1)) * 64 + (2 * (fq & 1) + n) * 16 + fr] : (f32x4){0.f, 0.f, 0.f, 0.f}; big[1][bj][m][n] = (f32x4){0.f, 0.f, 0.f, 0.f}; }
        Unit u; u.pm = MP_ / BM; u.pn = j;
        if constexpr (RT == 4) E(big, u, rsel, wc, fr, fq, 1 << w, lds + EPV_OFF); else E(big, u, rsel >> 1, wc, fr + 32 * (rsel & 1), fq, 1 << w, lds + EPV_OFF);
    }
    asm volatile("s_waitcnt lgkmcnt(0)" ::: "memory"); __builtin_amdgcn_s_barrier(); asm volatile("" ::: "memory");
}
__device__ __forceinline__ void glds16_m(const void* gsrc, unsigned lds_dst) { unsigned keep;
    asm volatile("s_mov_b32 %0, m0\n\ts_mov_b32 m0, %2\n\ts_nop 0\n\tglobal_load_lds_dwordx4 %1, off\n\ts_mov_b32 m0, %0" : "=&s"(keep) : "v"(gsrc), "s"(lds_dst) : "memory"); }
template <class Epi>
__device__ __forceinline__ void mini_ring(PG8_LAS unsigned char* lds, const bf16_t* A, const bf16_t* Bt, int K, const Epi& E, int mu, int wave_u) {
    constexpr int NS = 8, PD = 6, SLOT = 128 * 128;
    int tid_ = wave_u * 64 + lane_id_now(); asm volatile("" : "+v"(tid_));
    const int tid = tid_, w = __builtin_amdgcn_readfirstlane(tid >> 6), lane = tid & 63, fr = lane & 15, fq = lane >> 4;
    const int rsel = mu & 1, wc = (mu >> 1) & 3, j = mu >> 3, nchunk = K >> 6;
    epi_prefetch(E, MP_ / BM, j, (unsigned)__builtin_amdgcn_readfirstlane((int)((unsigned)(size_t)lds + (unsigned)EPV_OFF + (unsigned)w * 256u)), tid);
    const char* src[2];
#pragma unroll
    for (int i = 0; i < 2; ++i) { const int P = tid + 512 * i, row = P >> 3, q = (P & 7) ^ (row & 7);
        const bf16_t* rp = row < 64 ? A + (size_t)(MP_ + 64 * rsel + row) * K : Bt + (size_t)(256 * j + 128 * ((row - 64) >> 5) + 32 * wc + perm32((row - 64) & 31)) * K;
        src[i] = (const char*)rp + 16 * q; }
    const unsigned ldw = (unsigned)__builtin_amdgcn_readfirstlane((int)((unsigned)(size_t)lds + (unsigned)w * 1024u));
#define MR_ISSUE(c) do { const unsigned sb_ = ldw + (unsigned)(((c) & (NS - 1)) * SLOT); glds16_m(src[0] + (size_t)(c) * 128, sb_); glds16_m(src[1] + (size_t)(c) * 128, sb_ + 8192u); } while (0)
#pragma unroll
    for (int c = 0; c < PD; ++c) MR_ISSUE(c);
    f32x4 acc[2][2];
#pragma unroll
    for (int b = 0; b < 2; ++b)
#pragma unroll
        for (int n = 0; n < 2; ++n) acc[b][n] = (f32x4){0.f, 0.f, 0.f, 0.f};
    const int x0 = ((fq) ^ (fr & 7)) * 16, x1 = ((4 + fq) ^ (fr & 7)) * 16;
    const int aoff = (16 * (w & 3) + fr) * 128;
#define MR_CONSUME(c) do { if (w < 4) { const PG8_LAS unsigned char* sp = lds + ((c) & (NS - 1)) * SLOT; \
            const bf16x8 a0 = *(const PG8_LAS bf16x8*)(sp + aoff + x0), a1 = *(const PG8_LAS bf16x8*)(sp + aoff + x1); \
            _Pragma("unroll") for (int b = 0; b < 2; ++b) _Pragma("unroll") for (int n = 0; n < 2; ++n) { const int boff = (64 + 32 * b + 16 * n + fr) * 128; \
                const bf16x8 b0 = *(const PG8_LAS bf16x8*)(sp + boff + x0), b1 = *(const PG8_LAS bf16x8*)(sp + boff + x1); \
                acc[b][n] = __builtin_amdgcn_mfma_f32_16x16x32_bf16(b0, a0, acc[b][n], 0, 0, 0); \
                acc[b][n] = __builtin_amdgcn_mfma_f32_16x16x32_bf16(b1, a1, acc[b][n], 0, 0, 0); } \
            asm volatile("s_waitcnt lgkmcnt(0)" ::: "memory"); } } while (0)
    const int nmain = nchunk - PD;
#pragma unroll 1
    for (int c = 0; c < nmain; ++c) {
        MR_ISSUE(c + PD);
        asm volatile("s_waitcnt vmcnt(12)" ::: "memory"); __builtin_amdgcn_s_barrier(); asm volatile("" ::: "memory");
        MR_CONSUME(c);
    }
    asm volatile("s_waitcnt vmcnt(10)" ::: "memory"); __builtin_amdgcn_s_barrier(); asm volatile("" ::: "memory"); MR_CONSUME(nmain);
    asm volatile("s_waitcnt vmcnt(8)" ::: "memory"); __builtin_amdgcn_s_barrier(); asm volatile("" ::: "memory"); MR_CONSUME(nmain + 1);
    asm volatile("s_waitcnt vmcnt(6)" ::: "memory"); __builtin_amdgcn_s_barrier(); asm volatile("" ::: "memory"); MR_CONSUME(nmain + 2);
    asm volatile("s_waitcnt vmcnt(4)" ::: "memory"); __builtin_amdgcn_s_barrier(); asm volatile("" ::: "memory"); MR_CONSUME(nmain + 3);
    asm volatile("s_waitcnt vmcnt(2)" ::: "memory"); __builtin_amdgcn_s_barrier(); asm volatile("" ::: "memory"); MR_CONSUME(nmain + 4);
    asm volatile("s_waitcnt vmcnt(0)" ::: "memory"); __builtin_amdgcn_s_barrier(); asm volatile("" ::: "memory"); MR_CONSUME(nmain + 5);
#undef MR_CONSUME
#undef MR_ISSUE
    asm volatile("s_waitcnt vmcnt(0) lgkmcnt(0)" ::: "memory"); __builtin_amdgcn_s_barrier(); asm volatile("" ::: "memory");
    if (w < 4) {
        f32x4 big[2][2][4][2];
#pragma unroll
        for (int m = 0; m < 4; ++m)
#pragma unroll
            for (int bj = 0; bj < 2; ++bj)
#pragma unroll
                for (int n = 0; n < 2; ++n) { big[0][bj][m][n] = acc[bj][n]; big[1][bj][m][n] = (f32x4){0.f, 0.f, 0.f, 0.f}; }
        Unit u; u.pm = MP_ / BM; u.pn = j;
        E(big, u, rsel, wc, fr, fq, (1 << w) | 0x200, lds + EPV_OFF);
    }
    asm volatile("s_waitcnt lgkmcnt(0)" ::: "memory"); __builtin_amdgcn_s_barrier(); asm volatile("" ::: "memory");
}
__device__ __forceinline__ void glds16_asm(const void* gsrc, unsigned lds_dst) { unsigned keep;
    asm volatile("s_mov_b32 %0, m0\n\ts_mov_b32 m0, %2\n\ts_nop 0\n\tglobal_load_lds_dwordx4 %1, off\n\ts_mov_b32 m0, %0" : "=&s"(keep) : "v"(gsrc), "s"(lds_dst) : "memory"); }
typedef float f32x2_z __attribute__((ext_vector_type(2)));
__device__ __forceinline__ f32x4 zero4_pk() { f32x2_z a, b; asm volatile("v_pk_mov_b32 %0, 0, 0" : "=v"(a)); asm volatile("v_pk_mov_b32 %0, 0, 0" : "=v"(b)); return (f32x4){a.x, a.y, b.x, b.y}; }
template <class Epi, class Sched, bool ALIGN_EPI = false, bool SP2 = false>
__device__ __forceinline__ void gemm_phase(PG8_LAS unsigned char* lds, const Gemm g, const Sched& S, const Epi& E, int wave_u) {
    int tid_ = wave_u * 64 + lane_id_now(); asm volatile("" : "+v"(tid_));
    const int tid = tid_, wid = __builtin_amdgcn_readfirstlane(tid >> 6), lane = tid & 63, wr = wid >> 2, wc = wid & 3, fr = lane & 15, fq = lane >> 4;
    const int K = g.K, nt = K / BK;
    unsigned voffA[2], voffB[2];
#pragma unroll
    for (int i = 0; i < 2; ++i) { int R, C; stage_rc(tid * 16 + i * 8192, R, C); const int Rb = Epi::PERM ? ((R & ~31) + perm32(R & 31)) : R;
        voffA[i] = (unsigned)(R * K + C) * 2u; voffB[i] = (unsigned)(Rb * K + C) * 2u; }
    const size_t kstep = (size_t)(BK * 2);
    const size_t hstep = (size_t)HALF * K * 2;
    const size_t tstep = 2 * hstep;
    const unsigned ldsw = (unsigned)wid * 1024u;
    const unsigned ldsb = (unsigned)__builtin_amdgcn_readfirstlane((int)((unsigned)(size_t)lds + ldsw));
    const int aoff = lds_byte(wr * 64 + fr, fq * 8), boff = lds_byte(wc * 32 + fr, fq * 8);
#define PG8_SA(b, h) (((b) * 2 + (h)) * HTB)
#define PG8_SB(b, h) ((4 + (b) * 2 + (h)) * HTB)
#define PG8_STAGE(bufoff, gbase, voff) do { _Pragma("unroll") for (int _i = 0; _i < 2; ++_i) \
        glds16_asm((const char*)(gbase) + (voff)[_i], ldsb + (unsigned)((bufoff) + _i * 8192)); } while (0)
#define PG8_LDA(dst, b, h) do { _Pragma("unroll") for (int m = 0; m < 4; ++m) _Pragma("unroll") for (int k = 0; k < 2; ++k) dst[m][k] = *(const PG8_LAS bf16x8*)(lds + PG8_SA(b, h) + aoff + m * 2048 + k * 1024); } while (0)
#define PG8_LDB(dst, b, h) do { _Pragma("unroll") for (int n = 0; n < 2; ++n) _Pragma("unroll") for (int k = 0; k < 2; ++k) dst[n][k] = *(const PG8_LAS bf16x8*)(lds + PG8_SB(b, h) + boff + n * 2048 + k * 1024); } while (0)
#define PG8_MMA(ai, bj, At, Bt) do { __builtin_amdgcn_s_setprio(1); _Pragma("unroll") for (int m = 0; m < 4; ++m) _Pragma("unroll") for (int n = 0; n < 2; ++n) _Pragma("unroll") for (int k = 0; k < 2; ++k) \
        acc[ai][bj][m][n] = __builtin_amdgcn_mfma_f32_16x16x32_bf16(Bt[n][k], At[m][k], acc[ai][bj][m][n], 0, 0, 0); __builtin_amdgcn_s_setprio(0); } while (0)
#define PG8_WAIT_V(n) asm volatile("s_waitcnt vmcnt(" #n ")" ::: "memory")
#define PG8_WAIT_L(n) asm volatile("s_waitcnt lgkmcnt(" #n ")" ::: "memory")
#define PG8_BAR __builtin_amdgcn_s_barrier()
#define PG8_SCHED __builtin_amdgcn_sched_barrier(0)
    const unsigned evb = (unsigned)__builtin_amdgcn_readfirstlane((int)((unsigned)(size_t)lds + (unsigned)EPV_OFF + (unsigned)wid * 256u));
    Unit cur, nxt; int ui = 0;
    if (!S.next(0, cur)) return;
    f32x4 acc[2][2][4][2];
#pragma unroll
    for (int a = 0; a < 2; ++a)
#pragma unroll
        for (int b = 0; b < 2; ++b)
#pragma unroll
            for (int m = 0; m < 4; ++m)
#pragma unroll
                for (int n = 0; n < 2; ++n) acc[a][b][m][n] = zero4_pk();
    bf16x8 At[4][2], B0[2][2], B1[2][2];
    const char* cA = (const char*)g.A + (size_t)cur.pm * tstep; const char* cB = (const char*)g.Bt + (size_t)cur.pn * tstep;
    S.a_ready(cur);
    epi_prefetch(E, cur.pm, cur.pn, evb, tid);
    if constexpr (SP2) {
        PG8_STAGE(PG8_SB(0, 0), cB, voffB); PG8_STAGE(PG8_SB(0, 1), cB + hstep, voffB); PG8_STAGE(PG8_SA(0, 0), cA, voffA); PG8_STAGE(PG8_SA(0, 1), cA + hstep, voffA);
        if (wr == 1) PG8_BAR;
        PG8_WAIT_V(2); PG8_BAR;
        PG8_STAGE(PG8_SB(1, 0), cB + kstep, voffB); PG8_STAGE(PG8_SA(1, 0), cA + kstep, voffA); PG8_STAGE(PG8_SB(1, 1), cB + hstep + kstep, voffB);
        PG8_WAIT_V(6); PG8_BAR;
    } else {
        PG8_STAGE(PG8_SB(0, 0), cB, voffB); PG8_STAGE(PG8_SA(0, 0), cA, voffA); PG8_STAGE(PG8_SB(0, 1), cB + hstep, voffB); PG8_STAGE(PG8_SA(0, 1), cA + hstep, voffA);
        if (wr == 1) PG8_BAR;
        PG8_WAIT_V(4); PG8_BAR;
        PG8_STAGE(PG8_SB(1, 0), cB + kstep, voffB); PG8_STAGE(PG8_SA(1, 0), cA + kstep, voffA); PG8_STAGE(PG8_SB(1, 1), cB + hstep + kstep, voffB);
        PG8_WAIT_V(6); PG8_BAR;
    }
    for (;;) {
        const bool has_next = S.next(ui + 1, nxt);
        const char* nA = has_next ? (const char*)g.A + (size_t)nxt.pm * tstep : cA; const char* nB = has_next ? (const char*)g.Bt + (size_t)nxt.pn * tstep : cB;
        for (int t = 0; t < nt; t += 2) {
            const bool last = (t == nt - 2);
            const char* a1 = cA + (size_t)(t + 1) * kstep;
            const char* a2 = last ? nA : cA + (size_t)(t + 2) * kstep; const char* b2 = last ? nB : cB + (size_t)(t + 2) * kstep;
            const char* a3 = a2 + kstep; const char* b3 = b2 + kstep;
            if (last && has_next) { S.a_ready(nxt); epi_prefetch(E, nxt.pm, nxt.pn, evb + (unsigned)(((ui + 1) & 1) * EPV_BYTES), tid); }
            if constexpr (SP2) {
            PG8_LDB(B0, 0, 0); PG8_LDB(B1, 0, 1); PG8_SCHED; PG8_LDA(At, 0, 0); PG8_STAGE(PG8_SA(1, 1), a1 + hstep, voffA);
            PG8_WAIT_V(8); PG8_WAIT_L(0); PG8_BAR; PG8_MMA(0, 0, At, B0); PG8_MMA(0, 1, At, B1); PG8_BAR; PG8_SCHED;
            PG8_LDA(At, 0, 1); PG8_STAGE(PG8_SB(0, 0), b2, voffB); PG8_STAGE(PG8_SB(0, 1), b2 + hstep, voffB); PG8_STAGE(PG8_SA(0, 0), a2, voffA);
            PG8_WAIT_V(8); PG8_WAIT_L(0); PG8_BAR; PG8_MMA(1, 0, At, B0); PG8_MMA(1, 1, At, B1); PG8_BAR; PG8_SCHED;
            PG8_LDB(B0, 1, 0); PG8_LDB(B1, 1, 1); PG8_SCHED; PG8_LDA(At, 1, 0); PG8_STAGE(PG8_SA(0, 1), a2 + hstep, voffA);
            PG8_WAIT_V(8); PG8_WAIT_L(0); PG8_BAR; PG8_MMA(0, 0, At, B0); PG8_MMA(0, 1, At, B1); PG8_BAR; PG8_SCHED;
            PG8_LDA(At, 1, 1); PG8_STAGE(PG8_SB(1, 0), b3, voffB); PG8_STAGE(PG8_SB(1, 1), b3 + hstep, voffB); PG8_STAGE(PG8_SA(1, 0), a3, voffA);
            PG8_WAIT_V(8); PG8_WAIT_L(0); PG8_BAR; PG8_MMA(1, 0, At, B0); PG8_MMA(1, 1, At, B1); PG8_BAR; PG8_SCHED;
            } else {
            PG8_LDB(B0, 0, 0); PG8_SCHED; PG8_LDA(At, 0, 0); PG8_STAGE(PG8_SA(1, 1), a1 + hstep, voffA);
            PG8_WAIT_L(8); PG8_BAR; PG8_WAIT_L(0); PG8_MMA(0, 0, At, B0); PG8_BAR; PG8_SCHED;
            PG8_LDB(B1, 0, 1); PG8_STAGE(PG8_SB(0, 0), b2, voffB);
            PG8_BAR; PG8_WAIT_L(0); PG8_MMA(0, 1, At, B1); PG8_BAR;
            PG8_LDA(At, 0, 1); PG8_STAGE(PG8_SA(0, 0), a2, voffA);
            PG8_BAR; PG8_WAIT_L(0); PG8_MMA(1, 0, At, B0); PG8_BAR; PG8_SCHED;
            PG8_STAGE(PG8_SB(0, 1), b2 + hstep, voffB);
            PG8_WAIT_V(6); PG8_BAR; PG8_MMA(1, 1, At, B1); PG8_BAR;
            PG8_LDB(B0, 1, 0); PG8_SCHED; PG8_LDA(At, 1, 0); PG8_STAGE(PG8_SA(0, 1), a2 + hstep, voffA);
            PG8_WAIT_L(8); PG8_BAR; PG8_WAIT_L(0); PG8_MMA(0, 0, At, B0); PG8_BAR; PG8_SCHED;
            PG8_LDB(B1, 1, 1); PG8_STAGE(PG8_SB(1, 0), b3, voffB);
            PG8_BAR; PG8_WAIT_L(0); PG8_MMA(0, 1, At, B1); PG8_BAR;
            PG8_LDA(At, 1, 1); PG8_STAGE(PG8_SA(1, 0), a3, voffA);
            PG8_BAR; PG8_WAIT_L(0); PG8_MMA(1, 0, At, B0); PG8_BAR; PG8_SCHED;
            PG8_STAGE(PG8_SB(1, 1), b3 + hstep, voffB);
            PG8_WAIT_V(6); PG8_BAR; PG8_MMA(1, 1, At, B1); PG8_BAR;
            }
        }
        if constexpr (ALIGN_EPI) { if (wr == 0) PG8_BAR; }
        if constexpr (!Epi::AFTER_DRAIN) { E(acc, cur, wr, wc, fr, fq, 0xFF, lds + EPV_OFF + (ui & 1) * EPV_BYTES); S.done(cur); }
        if (!has_next) break;
#pragma unroll
        for (int a = 0; a < 2; ++a)
#pragma unroll
            for (int b = 0; b < 2; ++b)
#pragma unroll
                for (int m = 0; m < 4; ++m)
#pragma unroll
                    for (int n = 0; n < 2; ++n) acc[a][b][m][n] = zero4_pk();
        cur = nxt; cA = nA; cB = nB; ++ui;
        if constexpr (ALIGN_EPI) { if (wr == 1) PG8_BAR; }
    }
    PG8_WAIT_V(0);
    if constexpr (!ALIGN_EPI) { if (wr == 0) PG8_BAR; }
    PG8_BAR;
    if constexpr (Epi::AFTER_DRAIN) { E.fused(acc, cur, wr, wc, fr, fq, lds, wid, lane); S.done(cur); }
#undef PG8_SA
#undef PG8_SB
#undef PG8_STAGE
#undef PG8_LDA
#undef PG8_LDB
#undef PG8_MMA
#undef PG8_WAIT_V
#undef PG8_WAIT_L
#undef PG8_BAR
#undef PG8_SCHED
}
}

constexpr int NWAVES = 8;
constexpr int D = 1024, NB = 8, SEQ = 2048, DEC = 128, MP = NB * SEQ, MT = MP + DEC, MTP = 16640  ;
constexpr int HW = 512, NH = 4, DK = 128, DV = 128, CW = 512, CK = 31, DFF = 2816, EIN = 3072, NUP = 2 * DFF;
constexpr float LN_EPS = 1e-5f, RMS_EPS = 1e-6f;
constexpr size_t MiB = 1u << 20;
constexpr size_t WS_CTL = 0, CTL_ZERO_BYTES = 4 * MiB;
constexpr size_t WS_ZEROS = 512 * 1024;
constexpr size_t WS_STATS = 1 * MiB, STATS_BYTES = (size_t)MTP * 8;
constexpr size_t WS_SMALL = 3 * MiB;
constexpr size_t WS_STATS0 = WS_SMALL, WS_ONES = WS_SMALL + 256 * 1024, WS_LBS = WS_ONES + 4096, WS_CVEC = WS_SMALL + 512 * 1024;
constexpr size_t CVEC_LAYER = (size_t)(EIN + NUP) * 2;
constexpr size_t WS_W = 4 * MiB, W_LAYER = 49 * MiB / 2;
constexpr size_t W_IN = 0, W_OUT = 6 * MiB, W_13 = 8 * MiB, W_2 = 19 * MiB;
constexpr size_t WS_ZA = 102 * MiB, WS_ZB = 135 * MiB, WS_A2 = 168 * MiB, WS_PH = 201 * MiB, WS_TMP = 291 * MiB, WS_END = 324 * MiB;
static_assert(WS_STATS + 8 * STATS_BYTES <= WS_SMALL && WS_CVEC + 4 * CVEC_LAYER * 4 <= WS_W && WS_W + 4 * W_LAYER <= WS_ZA && WS_ZA + (size_t)MTP * D * 2 <= WS_ZB && WS_ZB + (size_t)MTP * D * 2 <= WS_A2 &&
              WS_A2 + (size_t)MTP * D * 2 <= WS_PH && WS_PH + (size_t)MTP * DFF * 2 <= WS_TMP && WS_TMP + (size_t)MTP * HW * 4 <= WS_END, "d_ws map");
constexpr int CW_XID = 176 * 1024, CW_NONLOC = CW_XID + 512, CW_XLOC = CW_XID + 1024;
constexpr int CW_TMO = 0, CW_CODE = 1, CW_BAR = 4096, CW_SCTR = 160 * 1024;
constexpr int RING_OFF = 0, RING_BYTES = 131072, LDSCTL_OFF = RING_BYTES, MISC_OFF = LDSCTL_OFF + 320, LDS_BYTES = 147456;
static_assert(pg8::EPV_OFF >= MISC_OFF + 256 && pg8::EPV_OFF + 2 * pg8::EPV_BYTES <= LDS_BYTES, "epilogue-vector buffers live above the ring and the barrier words");
#define GAS __attribute__((address_space(1)))
#define LAS __attribute__((address_space(3)))
typedef unsigned short bf16;
typedef unsigned v4u __attribute__((ext_vector_type(4)));
typedef unsigned v2u __attribute__((ext_vector_type(2)));
typedef float f32x4 __attribute__((ext_vector_type(4)));
typedef GAS unsigned gu32;
#define RLX_AGENT __ATOMIC_RELAXED, __HIP_MEMORY_SCOPE_AGENT
#define LDS_WAIT() asm volatile("s_waitcnt lgkmcnt(0)" ::: "memory")
#define VM_WAIT() asm volatile("s_waitcnt vmcnt(0)" ::: "memory")
typedef float f32x2_cv __attribute__((ext_vector_type(2)));
typedef __bf16 bf16x2_cv __attribute__((ext_vector_type(2)));
__device__ __forceinline__ unsigned pk2(float lo, float hi) { const f32x2_cv v = {lo, hi}; const bf16x2_cv b = __builtin_convertvector(v, bf16x2_cv); return __builtin_bit_cast(unsigned, b); }
__device__ __forceinline__ void st16_wt(void* p, f32x4 v) { asm volatile("global_store_dwordx4 %0, %1, off sc1\n\ts_nop 1" :: "v"(p), "v"(v) : "memory"); }
__device__ __forceinline__ void st2_wt(void* p, unsigned v) { asm volatile("global_store_short %0, %1, off sc1" :: "v"(p), "v"(v) : "memory"); }
__device__ __forceinline__ unsigned f2bf(float f) { return pk2(f, 0.f) & 0xffffu; }
__device__ __forceinline__ float bfr(float f) { return __uint_as_float(f2bf(f) << 16); }
__device__ __forceinline__ float b2f(bf16 b) { return __uint_as_float((unsigned)b << 16); }
#define XB_TMO      128
#define XB_XCNT(j)  (256  + 64 * (j))
#define XB_XSUB(j)  (1280 + 64 * (j))
#define XB_XGEN(j)  (2304 + 64 * (j))
#define XB_TOP      3328
#define XB_TOPGEN   3392
#define XCD_BAR_WORDS 3456
#define XB_SPIN_CAP (1u << 18)

__device__ __forceinline__ unsigned xb_ld(unsigned* p)              { return __hip_atomic_load(p, __ATOMIC_RELAXED, __HIP_MEMORY_SCOPE_AGENT); }
__device__ __forceinline__ unsigned xb_add(unsigned* p, unsigned v) { return __hip_atomic_fetch_add(p, v, __ATOMIC_RELAXED, __HIP_MEMORY_SCOPE_AGENT); }
__device__ __forceinline__ unsigned xb_xcc_id() { return (unsigned)__builtin_amdgcn_s_getreg((3 << 11) | 20) & 0xFu; }
#define XB_SPIN(cond, bar) do { unsigned _sp = 0; while (cond) { __builtin_amdgcn_s_sleep(1); \
    if ((++_sp & 255u) == 0u) { if (xb_ld(&(bar)[XB_TMO])) break; if (_sp > XB_SPIN_CAP) { atomicAdd(&(bar)[XB_TMO], 1u); break; } } } } while (0)

struct XcdBarrier {
    unsigned* bar; unsigned x;
    volatile LAS unsigned* st;
};

__device__ __forceinline__ XcdBarrier xcd_barrier_post(unsigned* bar, volatile LAS unsigned* st) {
    XcdBarrier b; b.bar = bar; b.x = xb_xcc_id(); b.st = st;
    if (threadIdx.x == 0) (void)xb_add(&bar[XB_XCNT(b.x)], 1u);
    return b;
}
__device__ __forceinline__ void xcd_barrier_complete(unsigned* bar, unsigned x, unsigned& nloc, unsigned& nx) {
    const unsigned G = gridDim.x * gridDim.y * gridDim.z;
    unsigned sum, cnt, mine, sp = 0u;
    for (;;) {
        sum = 0u; cnt = 0u; mine = 0u;
#pragma unroll
        for (unsigned j = 0; j < 16; ++j) { const unsigned c = xb_ld(&bar[XB_XCNT(j)]); sum += c; cnt += (c > 0u) ? 1u : 0u; mine = (j == x) ? c : mine; }
        if (sum == G) break;
        __builtin_amdgcn_s_sleep(1);
        if ((++sp & 255u) == 0u) { if (xb_ld(&bar[XB_TMO])) break; if (sp > XB_SPIN_CAP) { atomicAdd(&bar[XB_TMO], 1u); break; } }
    }
    nloc = mine > 0u ? mine : 1u; nx = cnt > 0u ? cnt : 1u;
}

__device__ __forceinline__ void xcd_barrier_t0(const XcdBarrier& b, const bool wb = true) {
    {
        unsigned* bar = b.bar;
        __builtin_amdgcn_s_waitcnt(0);
        unsigned nloc = b.st[0], nx = b.st[1];
        if (nloc == 0u) { xcd_barrier_complete(bar, b.x, nloc, nx); b.st[0] = nloc; b.st[1] = nx; }
        const unsigned old = xb_add(&bar[XB_XSUB(b.x)], 1u);
        const unsigned gen = old / nloc;
        if (old + 1u == (gen + 1u) * nloc) {
            if (wb) __builtin_amdgcn_fence(__ATOMIC_RELEASE, "agent");
            asm volatile("buffer_inv sc1" ::: "memory");
            asm volatile("s_waitcnt vmcnt(0)" ::: "memory");
            const unsigned og = xb_add(&bar[XB_TOP], 1u);
            const unsigned tg = og / nx;
            if (og + 1u == (tg + 1u) * nx) xb_add(&bar[XB_TOPGEN], 1u);
            else XB_SPIN(xb_ld(&bar[XB_TOPGEN]) == tg, bar);
            __builtin_amdgcn_fence(__ATOMIC_ACQUIRE, "workgroup");
            xb_add(&bar[XB_XGEN(b.x)], 1u);
            asm volatile("s_waitcnt vmcnt(0)" ::: "memory");
        } else {
            asm volatile("buffer_inv sc1" ::: "memory");
            XB_SPIN(xb_ld(&bar[XB_XGEN(b.x)]) == gen, bar);
            __builtin_amdgcn_fence(__ATOMIC_ACQUIRE, "workgroup");
            asm volatile("s_waitcnt vmcnt(0)" ::: "memory");
        }
    }
}
__device__ __forceinline__ void xcd_barrier(const XcdBarrier& b) {
    asm volatile("s_waitcnt vmcnt(0)" ::: "memory");
    __syncthreads();
    if (threadIdx.x == 0) {
        xcd_barrier_t0(b);
    }
    __syncthreads();
}

__device__ __forceinline__ void xcd_local_t0(const XcdBarrier& b, unsigned* ctr) {
    __builtin_amdgcn_s_waitcnt(0);
    unsigned nloc = b.st[0]; nloc = nloc ? nloc : 1u;
    asm volatile("buffer_inv sc1" ::: "memory");
    const unsigned old = xb_add(ctr, 1u);
    const unsigned target = (old / nloc + 1u) * nloc;
    XB_SPIN(xb_ld(ctr) < target, b.bar);
    __builtin_amdgcn_fence(__ATOMIC_ACQUIRE, "workgroup");
    asm volatile("s_waitcnt vmcnt(0)" ::: "memory");
}
__device__ __forceinline__ void xcd_seam_local(const XcdBarrier& b, unsigned* ctr, const unsigned* nonlocal_flag) {
    asm volatile("s_waitcnt vmcnt(0)" ::: "memory");
    __syncthreads();
    if (threadIdx.x == 0) {
        unsigned f = b.st[2];
        if (f == 0u) { f = xb_ld(const_cast<unsigned*>(nonlocal_flag)) + 1u; b.st[2] = f; }
        if (f == 1u) xcd_local_t0(b, ctr); else xcd_barrier_t0(b);
    }
    __syncthreads();
}

__device__ __forceinline__ void xcd_barrier_light(const XcdBarrier& b, const unsigned* nonlocal_flag) {
    asm volatile("s_waitcnt vmcnt(0)" ::: "memory");
    __syncthreads();
    if (threadIdx.x == 0) {
        unsigned f = b.st[2];
        if (f == 0u) { f = xb_ld(const_cast<unsigned*>(nonlocal_flag)) + 1u; b.st[2] = f; }
        xcd_barrier_t0(b, f != 1u);
    }
    __syncthreads();
}
struct Args { const float* in[23]; float* out; unsigned char* ws; int ph_lo, ph_hi, li, pad; };
struct Frame { LAS unsigned char* lds; int tid, lane, wave, vcu, G; };
__device__ __forceinline__ Frame phase_frame(const Frame& F0) { Frame F = F0; int t = F0.wave * 64 + lane_id_now(); asm volatile("" : "+v"(t)); F.tid = t; F.lane = t & 63; F.wave = F0.wave; return F; }

struct PItem { const float* W; int N, K; const float* g; const float* be; bf16* WT; int drow0, k0, n0; float* c1; float* c2; };
__device__ __forceinline__ void p0_item_load(const PItem& it, int lane, f32x4 (&v)[8]) {
#pragma unroll
    for (int i = 0; i < 8; ++i) v[i] = __builtin_nontemporal_load((const GAS f32x4*)(it.W + (size_t)(it.k0 + 8 * i + (lane >> 3)) * it.N + it.n0 + 4 * (lane & 7)));
}
__device__ __forceinline__ void p0_item_process(const PItem& it, int lane, const f32x4 (&v)[8], LAS float* scr) {
    LAS float* gl = scr + 64 * 36 + 32; LAS float* bl = gl + 64;
#define SCR_ROW(r) ((r) * 36 + 4 * ((r) >> 3))
#pragma unroll
    for (int i = 0; i < 8; ++i) *(LAS f32x4*)(scr + SCR_ROW(8 * i + (lane >> 3)) + 4 * (lane & 7)) = v[i];
    gl[lane] = it.g ? it.g[it.k0 + lane] : 1.f; bl[lane] = it.be ? it.be[it.k0 + lane] : 0.f;
    LDS_WAIT(); asm volatile("" ::: "memory");
    if (it.c1) { const int n = lane & 31, kh = lane >> 5; float s1 = 0.f, s2 = 0.f;
#pragma unroll 8
        for (int kk = 0; kk < 32; ++kk) { const int k = 32 * kh + kk; const float x = scr[SCR_ROW(k) + n]; s1 += bfr(gl[k] * x); s2 += bl[k] * x; }
        s1 += __shfl_xor(s1, 32); s2 += __shfl_xor(s2, 32);
        if (lane < 32) { atomicAdd(it.c1 + it.drow0 + n, s1); if (it.be) atomicAdd(it.c2 + it.drow0 + n, s2); } }
    const int c = lane & 7;
    const f32x4 g0 = *(const LAS f32x4*)(gl + 8 * c), g1 = *(const LAS f32x4*)(gl + 8 * c + 4);
#pragma unroll
    for (int j = 0; j < 4; ++j) { const int n = (lane >> 3) + 8 * j; const LAS float* sp = scr + SCR_ROW(8 * c) + n;
        v4u o; o.x = pk2(sp[0 * 36] * g0[0], sp[1 * 36] * g0[1]); o.y = pk2(sp[2 * 36] * g0[2], sp[3 * 36] * g0[3]); o.z = pk2(sp[4 * 36] * g1[0], sp[5 * 36] * g1[1]); o.w = pk2(sp[6 * 36] * g1[2], sp[7 * 36] * g1[3]);
        st16_wt((void*)(it.WT + (size_t)(it.drow0 + n) * it.K + it.k0 + 8 * c), __builtin_bit_cast(f32x4, o)); }
    LDS_WAIT(); asm volatile("" ::: "memory");
}
__device__ __forceinline__ int in_src_col(int j, int odd) {
    const int jt = j >> 8, jo = j & 255, nplain = odd ? 4 : 8;
    if (jt < nplain) return j;
    const int i = jt - nplain, first = odd ? 1024 : 2048, second = odd ? 2048 : 2560;
    return (jo < 128) ? first + 128 * i + jo : second + 128 * i + (jo - 128);
}
__device__ __forceinline__ int in_dst_row(int n, int odd) {
    const int first = odd ? 1024 : 2048, second = odd ? 2048 : 2560;
    if (n < first) return n;
    if (n < second) { const int i = (n - first) >> 7, o = (n - first) & 127; return first + 256 * i + o; }
    const int i = (n - second) >> 7, o = (n - second) & 127; return first + 256 * i + 128 + o;
}
__device__ __forceinline__ PItem p0_decode(const Args& a, int it) {
    constexpr int I_IN = 16 * 96, I_OUT = 16 * 32, I_W1 = 16 * 88, I_W2 = 44 * 32, I_LAYER = I_IN + I_OUT + 2 * I_W1 + I_W2;
    const int l = it / I_LAYER, e = l >> 1, odd = l & 1; int r = it % I_LAYER;
    unsigned char* wl = a.ws + WS_W + (size_t)l * W_LAYER; float* cv = (float*)(a.ws + WS_CVEC) + (size_t)l * CVEC_LAYER;
    PItem p;
    if (r < I_IN) { const int kb = r / 96, nb = r % 96; p.W = (odd ? a.in[13] : a.in[5]) + (size_t)e * D * EIN; p.N = EIN; p.K = D; p.g = l > 0 ? a.in[21] + (size_t)(l - 1) * D : nullptr; p.be = l > 0 ? a.in[22] + (size_t)(l - 1) * D : nullptr;
        p.WT = (bf16*)(wl + W_IN); p.drow0 = in_dst_row(32 * nb, odd); p.k0 = 64 * kb; p.n0 = 32 * nb; p.c1 = cv; p.c2 = cv + EIN; return p; } r -= I_IN;
    if (r < I_OUT) { const int kb = r / 32, nb = r % 32; p.W = (odd ? a.in[15] : a.in[6]) + (size_t)e * D * D; p.N = D; p.K = D; p.g = nullptr; p.be = nullptr;
        p.WT = (bf16*)(wl + W_OUT); p.drow0 = 32 * nb; p.k0 = 64 * kb; p.n0 = 32 * nb; p.c1 = nullptr; p.c2 = nullptr; return p; } r -= I_OUT;
    if (r < 2 * I_W1) { const int second = r >= I_W1; if (second) r -= I_W1; const int kb = r / 88, nb = r % 88, n0 = 32 * nb; p.W = (second ? a.in[17] : a.in[16]) + (size_t)l * D * DFF; p.N = DFF; p.K = D;
        p.g = a.in[19] + (size_t)l * D; p.be = a.in[20] + (size_t)l * D; p.WT = (bf16*)(wl + W_13); p.drow0 = 256 * (n0 >> 7) + (second ? 128 : 0) + (n0 & 127); p.k0 = 64 * kb; p.n0 = n0; p.c1 = cv + 2 * EIN; p.c2 = cv + 2 * EIN + NUP; return p; } r -= 2 * I_W1;
    { const int kb = r / 32, nb = r % 32; p.W = a.in[18] + (size_t)l * DFF * D; p.N = D; p.K = DFF; p.g = nullptr; p.be = nullptr; p.WT = (bf16*)(wl + W_2); p.drow0 = 32 * nb; p.k0 = 64 * kb; p.n0 = 32 * nb; p.c1 = nullptr; p.c2 = nullptr; return p; }
}
__device__ __forceinline__ void p0_convert(const Frame& F, const Args& a, int it_lo, int it_hi, int widx, int nw, LAS float* scr) {
    const int it0 = it_lo + widx, itend = it_hi;
    if (it0 < itend) {
        PItem cur = p0_decode(a, it0); f32x4 vc[8]; p0_item_load(cur, F.lane, vc);
        for (int it = it0; it < itend; it += nw) {
            const bool more = it + nw < itend;
            PItem nxt = cur; f32x4 vn[8];
            if (more) { nxt = p0_decode(a, it + nw); p0_item_load(nxt, F.lane, vn); }
            p0_item_process(cur, F.lane, vc, scr);
            if (more) { cur = nxt;
#pragma unroll
                for (int i = 0; i < 8; ++i) vc[i] = vn[i]; }
        }
    }
}
constexpr int P_ILAYER = 16 * 96 + 16 * 32 + 2 * 16 * 88 + 44 * 32, P_IIN = 16 * 96, P_IW2 = 44 * 32;
__device__ __forceinline__ void p_convert_tail(const Frame& F0, const Args& a, int it_lo, int it_hi, int wg_idx, int n_wgs) {
    const Frame F = phase_frame(F0);
    p0_convert(F, a, it_lo, it_hi, wg_idx * NWAVES + F.wave, n_wgs * NWAVES, (LAS float*)(F.lds + RING_OFF + F.wave * 16384));
}
__device__ __forceinline__ void p_state_copies_tail(const Frame& F0, const Args& a, int wg_idx, int n_wgs) {
    const Frame F = phase_frame(F0);
    const size_t gt = ((size_t)wg_idx * NWAVES + F.wave) * 64 + F.lane, NGT = (size_t)n_wgs * NWAVES * 64;
    float* o_cs = a.out + (size_t)MT * D + (size_t)2 * NB * NH * DK * DV + (size_t)2 * NB * 30 * CW + (size_t)2 * NB * 2 * D + (size_t)2 * DEC * NH * DK * DV;
    float* o_ss = o_cs + (size_t)2 * DEC * 30 * CW;
    constexpr size_t NC = (size_t)2 * DEC * 29 * (CW / 4);
    for (size_t i0 = gt; i0 < NC; i0 += 4 * NGT) { f32x4 t[4];
#pragma unroll
        for (int q = 0; q < 4; ++q) { const size_t i = i0 + q * NGT; if (i < NC) { const size_t c4 = i % (CW / 4), r = i / (CW / 4), ii = r % 29, eb = r / 29; t[q] = __builtin_nontemporal_load((const f32x4*)(a.in[3] + (eb * 30 + ii + 1) * CW + c4 * 4)); } }
#pragma unroll
        for (int q = 0; q < 4; ++q) { const size_t i = i0 + q * NGT; if (i < NC) { const size_t c4 = i % (CW / 4), r = i / (CW / 4), ii = r % 29, eb = r / 29; st16_wt(o_cs + (eb * 30 + ii) * CW + c4 * 4, t[q]); } } }
    for (size_t i = gt; i < (size_t)2 * DEC * (D / 4); i += NGT) { const size_t c4 = i % (D / 4), eb = i / (D / 4);
        *(f32x4*)(o_ss + (eb * 2 + 0) * D + c4 * 4) = *(const f32x4*)(a.in[4] + (eb * 2 + 1) * D + c4 * 4); }
}
__device__ __forceinline__ void p0_prologue(const Frame& F0, const Args& a) {
    const Frame F = phase_frame(F0);
    unsigned char* ws = a.ws;
    LAS float* scr = (LAS float*)(F.lds + RING_OFF + F.wave * 16384);
    const int gw = F.vcu * NWAVES + F.wave, NGW = F.G * NWAVES;
    p0_convert(F, a, 0, 16 * 96, gw, NGW, scr);
    for (int m0 = gw; m0 < MTP; m0 += 4 * NGW) {
        f32x4 v[4][4];
#pragma unroll
        for (int q = 0; q < 4; ++q) { const int m = m0 + q * NGW;
            if (m < MT) { const GAS f32x4* xr = (const GAS f32x4*)(m < MP ? a.in[0] + (size_t)m * D : a.in[1] + (size_t)(m - MP) * D) + F.lane;
#pragma unroll
                for (int j = 0; j < 4; ++j) v[q][j] = __builtin_nontemporal_load(xr + 64 * j); }
            else {
#pragma unroll
                for (int j = 0; j < 4; ++j) v[q][j] = (f32x4){0.f, 0.f, 0.f, 0.f}; } }
#pragma unroll
        for (int q = 0; q < 4; ++q) { const int m = m0 + q * NGW;
            if (m < MTP) { GAS unsigned long long* o8 = (GAS unsigned long long*)((bf16*)(ws + WS_ZA) + (size_t)m * D) + F.lane;
#pragma unroll
                for (int j = 0; j < 4; ++j) o8[64 * j] = (unsigned long long)pk2(v[q][j].x, v[q][j].y) | ((unsigned long long)pk2(v[q][j].z, v[q][j].w) << 32); } }
    }
    const size_t gt = (size_t)gw * 64 + F.lane, NGT = (size_t)NGW * 64;
    for (size_t i = gt; i < (size_t)MTP; i += NGT) { float* s0 = (float*)(ws + WS_STATS0) + 2 * i; s0[0] = 0.f; s0[1] = 1024.f * (1.f - LN_EPS); }
    for (size_t i = gt; i < 1024; i += NGT) { ((float*)(ws + WS_ONES))[i] = 1.f;
        const int c = (int)i & 511; const float l0 = a.in[7][c], l1 = a.in[7][HW + c], mx = fmaxf(l0, l1), e0 = expf(l0 - mx), e1 = expf(l1 - mx);
        ((float*)(ws + WS_LBS))[i] = (i < 512) ? 0.f : e1 / (e0 + e1); }
}
__device__ __forceinline__ void sample_publish(const Frame& F0, unsigned* ctr, unsigned n) {
    if (F0.wave == 0 && lane_id_now() == 0) {
        asm volatile("s_waitcnt vmcnt(0)" ::: "memory");
        (void)__hip_atomic_fetch_add(ctr, n, __ATOMIC_RELAXED, __HIP_MEMORY_SCOPE_AGENT);
    }
}
__device__ __forceinline__ void sample_wait(const Frame& F0, unsigned* ctr, unsigned want) {
    if (F0.wave == 0 && lane_id_now() == 0) {
        unsigned sp = 0u;
        while (__hip_atomic_load(ctr, __ATOMIC_RELAXED, __HIP_MEMORY_SCOPE_AGENT) < want) { __builtin_amdgcn_s_sleep(2); if (++sp > (1u << 20)) break; }
        __builtin_amdgcn_fence(__ATOMIC_ACQUIRE, "agent");
        asm volatile("s_waitcnt vmcnt(0)" ::: "memory");
    }
    __syncthreads();
}
__device__ __forceinline__ void p_final_ln(const Frame& F0, const Args& a) {
    const Frame F = phase_frame(F0);
    const int gw = F.vcu * NWAVES + F.wave, NGW = F.G * NWAVES;
    const float* st = (const float*)(a.ws + WS_STATS + 7 * STATS_BYTES); const float* w = a.in[21] + 3 * D; const float* b = a.in[22] + 3 * D;
    f32x4 wv[4], bv[4];
#pragma unroll
    for (int j = 0; j < 4; ++j) { wv[j] = *((const f32x4*)w + 64 * j + F.lane); bv[j] = *((const f32x4*)b + 64 * j + F.lane); }
    const bf16* Z = (const bf16*)(a.ws + WS_ZA);
    for (int m0 = gw; m0 < MT; m0 += 8 * NGW) {
        v2u v[8][4]; float rA[8], rB[8];
#pragma unroll
        for (int q = 0; q < 8; ++q) { const int m = m0 + q * NGW < MT ? m0 + q * NGW : MT - 1; pg8::ln_row(st, m, rA[q], rB[q]);
            const GAS v2u* xr = (const GAS v2u*)(Z + (size_t)m * D) + F.lane;
#pragma unroll
            for (int j = 0; j < 4; ++j) v[q][j] = __builtin_nontemporal_load(xr + 64 * j); }
#pragma unroll
        for (int q = 0; q < 8; ++q) { const int m = m0 + q * NGW; if (m < MT) { GAS f32x4* xr = (GAS f32x4*)(a.out + (size_t)m * D) + F.lane;
#pragma unroll
            for (int j = 0; j < 4; ++j) { const f32x4 x = {pg8::bf_lo(v[q][j].x), pg8::bf_hi(v[q][j].x), pg8::bf_lo(v[q][j].y), pg8::bf_hi(v[q][j].y)}; st16_wt((void*)(xr + 64 * j), (x * rA[q] + rB[q]) * wv[j] + bv[j]); } } }
    }
}
typedef short bf16x8 __attribute__((ext_vector_type(8)));
constexpr int H_QT = 0, H_KT = 17408, H_KTT = 34816, H_VTT = 53248, H_P = 71680, H_ST = 80896, H_TOT = 115712, H_VEC = 117760;
constexpr int LDQ = 272, LD64 = 144;
constexpr size_t TMP_SF = 0, TMP_DS = 16 * MiB;
__device__ __forceinline__ f32x4 mfma16(bf16x8 a, bf16x8 b, f32x4 c) { return __builtin_amdgcn_mfma_f32_16x16x32_bf16(a, b, c, 0, 0, 0); }
__device__ __forceinline__ void hgrn_pass1(const Frame& F, unsigned char* ws) {
    bf16* PB = (bf16*)(ws + WS_PH);
    LAS unsigned char* L = F.lds + RING_OFF;
    const int k = F.tid & 127, qd = F.tid >> 7, w = F.wave, li = F.lane & 15, lq = F.lane >> 4;
    LAS float* TOT = (LAS float*)(L + H_TOT); LAS float* VEC = (LAS float*)(L + H_VEC);
    for (int unit = F.vcu; unit < 256; unit += F.G) {
        const int b = unit >> 5, h = (unit >> 3) & 3, seg = unit & 7, row_base = b * SEQ + seg * 256;
        f32x4 S[8];
#pragma unroll
        for (int vt = 0; vt < 8; ++vt) S[vt] = (f32x4){0.f, 0.f, 0.f, 0.f};
        float Bprev = 0.f;
        unsigned short rq[16], rl[16], rv[16];
        { const bf16* p0 = PB + (size_t)(row_base + qd * 16) * 2560 + h * 128 + k;
#pragma unroll
          for (int i = 0; i < 16; ++i) { const bf16* p = p0 + (size_t)i * 2560; rq[i] = p[0]; rl[i] = p[512]; rv[i] = p[1024]; } }
        for (int c = 0; c < 4; ++c) {
            bf16* prow = PB + (size_t)(row_base + c * 64 + qd * 16) * 2560 + h * 128 + k;
            float lf[16], qh[16]; unsigned vr[16];
#pragma unroll
            for (int i = 0; i < 16; ++i) { qh[i] = b2f(rq[i]); lf[i] = b2f(rl[i]); vr[i] = rv[i]; }
            if (c < 3) { const bf16* p0 = prow + (size_t)64 * 2560;
#pragma unroll
                for (int i = 0; i < 16; ++i) { const bf16* p = p0 + (size_t)i * 2560; rq[i] = p[0]; rl[i] = p[512]; rv[i] = p[1024]; } }
            float cs[16]; cs[0] = lf[0];
#pragma unroll
            for (int i = 1; i < 16; ++i) cs[i] = cs[i - 1] + lf[i];
            TOT[qd * 128 + k] = cs[15];
            __syncthreads();
            const float t0 = TOT[k], t1 = TOT[128 + k], t2 = TOT[256 + k], t3 = TOT[384 + k];
            const float off = (qd > 0 ? t0 : 0.f) + (qd > 1 ? t1 : 0.f) + (qd > 2 ? t2 : 0.f), bref = t0 + t1, btot = bref + t2 + t3;
            const float eqb = __expf(bref + Bprev);
            unsigned ktp[8], vtp[8];
#pragma unroll
            for (int i = 0; i < 16; ++i) {
                const float d = fminf(fmaxf(cs[i] + off - bref, -80.f), 80.f);
                const float E1 = __expf(d), E2 = __expf(-d), f = __expf(lf[i]);
                const float qt = qh[i] * E1, kt = (1.f - f) * E2;
                const int t = qd * 16 + i; const unsigned kb = f2bf(kt);
                *(LAS bf16*)(L + H_QT + t * LDQ + k * 2) = (bf16)f2bf(qt);
                *(LAS bf16*)(L + H_KT + t * LDQ + k * 2) = (bf16)kb;
                if (i & 1) { ktp[i >> 1] |= kb << 16; vtp[i >> 1] |= vr[i] << 16; } else { ktp[i >> 1] = kb; vtp[i >> 1] = vr[i]; }
                prow[(size_t)i * 2560] = (bf16)f2bf(qt * eqb);
            }
            *(LAS v4u*)(L + H_KTT + k * LD64 + qd * 32) = (v4u){ktp[0], ktp[1], ktp[2], ktp[3]}; *(LAS v4u*)(L + H_KTT + k * LD64 + qd * 32 + 16) = (v4u){ktp[4], ktp[5], ktp[6], ktp[7]};
            *(LAS v4u*)(L + H_VTT + k * LD64 + qd * 32) = (v4u){vtp[0], vtp[1], vtp[2], vtp[3]}; *(LAS v4u*)(L + H_VTT + k * LD64 + qd * 32 + 16) = (v4u){vtp[4], vtp[5], vtp[6], vtp[7]};
            if (qd == 0) { VEC[k] = __expf(bref); VEC[128 + k] = __expf(btot - bref); }
            Bprev += btot;
            __syncthreads();
            { const f32x4 eb = *(const LAS f32x4*)(VEC + 16 * w + 4 * lq);
#pragma unroll
              for (int vt = 0; vt < 8; ++vt) { S[vt] = S[vt] * eb;
                  *(LAS v2u*)(L + H_ST + (16 * vt + li) * LDQ + (16 * w + 4 * lq) * 2) = (v2u){pk2(S[vt][0], S[vt][1]), pk2(S[vt][2], S[vt][3])}; } }
            { const int ti = w >> 1;
#pragma unroll
              for (int q2 = 0; q2 < 2; ++q2) { const int si = 2 * (w & 1) + q2; f32x4 acc = {0.f, 0.f, 0.f, 0.f};
                  if (si <= ti) {
#pragma unroll
                      for (int ks = 0; ks < 4; ++ks) acc = mfma16(*(const LAS bf16x8*)(L + H_KT + (16 * si + li) * LDQ + (32 * ks + 8 * lq) * 2), *(const LAS bf16x8*)(L + H_QT + (16 * ti + li) * LDQ + (32 * ks + 8 * lq) * 2), acc);
                      if (si == ti) {
#pragma unroll
                          for (int r = 0; r < 4; ++r) if (4 * lq + r > li) acc[r] = 0.f; } }
                  *(LAS v2u*)(L + H_P + (16 * ti + li) * LD64 + (16 * si + 4 * lq) * 2) = (v2u){pk2(acc[0], acc[1]), pk2(acc[2], acc[3])}; } }
            __syncthreads();
            { const int ti = w & 3, vt0 = 4 * (w >> 2), nps = (ti >> 1) + 1;
              bf16x8 qf[4], pf[2];
#pragma unroll
              for (int ks = 0; ks < 4; ++ks) qf[ks] = *(const LAS bf16x8*)(L + H_QT + (16 * ti + li) * LDQ + (32 * ks + 8 * lq) * 2);
#pragma unroll
              for (int ks = 0; ks < 2; ++ks) pf[ks] = *(const LAS bf16x8*)(L + H_P + (16 * ti + li) * LD64 + (32 * ks + 8 * lq) * 2);
              bf16* orow = PB + (size_t)(row_base + c * 64 + 16 * ti + li) * 2560 + 1024 + h * 128 + 4 * lq;
#pragma unroll
              for (int j = 0; j < 4; ++j) { const int vrow = 16 * (vt0 + j) + li; f32x4 acc = {0.f, 0.f, 0.f, 0.f};
#pragma unroll
                  for (int ks = 0; ks < 4; ++ks) acc = mfma16(*(const LAS bf16x8*)(L + H_ST + vrow * LDQ + (32 * ks + 8 * lq) * 2), qf[ks], acc);
                  acc = mfma16(*(const LAS bf16x8*)(L + H_VTT + vrow * LD64 + (8 * lq) * 2), pf[0], acc);
                  if (nps > 1) acc = mfma16(*(const LAS bf16x8*)(L + H_VTT + vrow * LD64 + (32 + 8 * lq) * 2), pf[1], acc);
                  *(v2u*)(orow + 16 * (vt0 + j)) = (v2u){pk2(acc[0], acc[1]), pk2(acc[2], acc[3])}; } }
            { bf16x8 kf[2];
#pragma unroll
              for (int ks = 0; ks < 2; ++ks) kf[ks] = *(const LAS bf16x8*)(L + H_KTT + (16 * w + li) * LD64 + (32 * ks + 8 * lq) * 2);
              const f32x4 cf = *(const LAS f32x4*)(VEC + 128 + 16 * w + 4 * lq);
#pragma unroll
              for (int vt = 0; vt < 8; ++vt) {
#pragma unroll
                  for (int ks = 0; ks < 2; ++ks) S[vt] = mfma16(kf[ks], *(const LAS bf16x8*)(L + H_VTT + (16 * vt + li) * LD64 + (32 * ks + 8 * lq) * 2), S[vt]);
                  S[vt] = S[vt] * cf; } }
        }
        float* SF = (float*)(ws + WS_TMP + TMP_SF) + (size_t)unit * 16384;
#pragma unroll
        for (int vt = 0; vt < 8; ++vt)
#pragma unroll
            for (int r = 0; r < 4; ++r) SF[(16 * w + 4 * lq + r) * 128 + 16 * vt + li] = S[vt][r];
        if (qd == 0) ((float*)(ws + WS_TMP + TMP_DS))[unit * 128 + k] = __expf(Bprev);
        __syncthreads();
    }
}
__device__ __forceinline__ void hgrn_pass2(const Frame& F, unsigned char* ws, const float* gw, float* o_state  ) {
    bf16* PB = (bf16*)(ws + WS_PH); bf16* A2 = (bf16*)(ws + WS_A2);
    LAS unsigned char* L = F.lds + RING_OFF;
    const int w = F.wave, li = F.lane & 15, lq = F.lane >> 4, v4 = (F.tid & 31) * 4, kg = F.tid >> 5;
    const float* SFall = (const float*)(ws + WS_TMP + TMP_SF); const float* DSall = (const float*)(ws + WS_TMP + TMP_DS);
    for (int unit = F.vcu; unit < 256; unit += F.G) {
        const int b = unit >> 5, h = (unit >> 3) & 3, seg = unit & 7, row_base = b * SEQ + seg * 256;
        f32x4 Sin[8];
#pragma unroll
        for (int i = 0; i < 8; ++i) Sin[i] = (f32x4){0.f, 0.f, 0.f, 0.f};
        for (int j0 = 0; j0 < seg; j0 += 2) {
            f32x4 sf[2][8]; float dj[2][8];
#pragma unroll
            for (int jj = 0; jj < 2; ++jj) if (j0 + jj < seg) { const float* SFj = SFall + (size_t)(unit - seg + j0 + jj) * 16384; const float* Dj = DSall + (size_t)(unit - seg + j0 + jj) * 128;
#pragma unroll
                for (int i = 0; i < 8; ++i) { const int kk = kg * 8 + i; sf[jj][i] = *(const f32x4*)(SFj + kk * 128 + v4); dj[jj][i] = Dj[kk]; } }
#pragma unroll
            for (int jj = 0; jj < 2; ++jj) if (j0 + jj < seg) {
#pragma unroll
                for (int i = 0; i < 8; ++i) Sin[i] = Sin[i] * dj[jj][i] + sf[jj][i]; }
        }
        if (seg == 7) { const float* SF7 = SFall + (size_t)unit * 16384; const float* D7 = DSall + (size_t)unit * 128; float* dst = o_state + (size_t)(b * NH + h) * 16384;
#pragma unroll
            for (int i = 0; i < 8; ++i) { const int kk = kg * 8 + i; *(f32x4*)(dst + kk * 128 + v4) = Sin[i] * D7[kk] + *(const f32x4*)(SF7 + kk * 128 + v4); } }
        if (seg > 0) {
#pragma unroll
            for (int c4 = 0; c4 < 4; ++c4) *(LAS v4u*)(L + (v4 + c4) * LDQ + (kg * 8) * 2) = (v4u){pk2(Sin[0][c4], Sin[1][c4]), pk2(Sin[2][c4], Sin[3][c4]), pk2(Sin[4][c4], Sin[5][c4]), pk2(Sin[6][c4], Sin[7][c4])}; }
        __syncthreads();
#pragma unroll 1
        for (int u2 = 0; u2 < 2; ++u2) { const int idx = 2 * w + u2, row = row_base + (idx >> 2) * 64 + 16 * (idx & 3) + li;
            const bf16* prow = PB + (size_t)row * 2560 + h * 128;
            f32x4 o[8]; v2u gpre[8];
#pragma unroll
            for (int vt = 0; vt < 8; ++vt) gpre[vt] = *(const v2u*)(prow + 1536 + 16 * vt + 4 * lq);
#pragma unroll
            for (int vt = 0; vt < 8; ++vt) { const v2u raw = *(const v2u*)(prow + 1024 + 16 * vt + 4 * lq); o[vt] = (f32x4){pg8::bf_lo(raw.x), pg8::bf_hi(raw.x), pg8::bf_lo(raw.y), pg8::bf_hi(raw.y)}; }
            if (seg > 0) { bf16x8 qf[4];
#pragma unroll
                for (int ks = 0; ks < 4; ++ks) qf[ks] = *(const bf16x8*)(prow + 32 * ks + 8 * lq);
#pragma unroll
                for (int vt = 0; vt < 8; ++vt)
#pragma unroll
                    for (int ks = 0; ks < 4; ++ks) o[vt] = mfma16(*(const LAS bf16x8*)(L + (16 * vt + li) * LDQ + (32 * ks + 8 * lq) * 2), qf[ks], o[vt]); }
            float ss = 0.f;
#pragma unroll
            for (int vt = 0; vt < 8; ++vt) ss += (o[vt][0] * o[vt][0] + o[vt][1] * o[vt][1]) + (o[vt][2] * o[vt][2] + o[vt][3] * o[vt][3]);
            ss += __shfl_xor(ss, 16); ss += __shfl_xor(ss, 32);
            const float sc = rsqrtf(ss * (1.f / DV) + RMS_EPS);
#pragma unroll
            for (int vt = 0; vt < 8; ++vt) { const int v = 16 * vt + 4 * lq; const f32x4 gn = *(const f32x4*)(gw + v); const v2u graw = gpre[vt];
                const f32x4 g = {pg8::bf_lo(graw.x), pg8::bf_hi(graw.x), pg8::bf_lo(graw.y), pg8::bf_hi(graw.y)}; const f32x4 r = o[vt] * sc * gn * g;
                *(v2u*)(A2 + (size_t)row * D + h * 128 + v) = (v2u){pk2(r[0], r[1]), pk2(r[2], r[3])}; } }
        __syncthreads();
    }
}
__device__ __forceinline__ float wave_dpp_add(float v, int ctrl_sel) {
    const int x = __float_as_int(v);
    int y;
    if (ctrl_sel == 0) y = __builtin_amdgcn_update_dpp(0, x, 0xB1, 0xF, 0xF, true);
    else if (ctrl_sel == 1) y = __builtin_amdgcn_update_dpp(0, x, 0x4E, 0xF, 0xF, true);
    else if (ctrl_sel == 2) y = __builtin_amdgcn_update_dpp(0, x, 0x141, 0xF, 0xF, true);
    else y = __builtin_amdgcn_update_dpp(0, x, 0x140, 0xF, 0xF, true);
    return v + __int_as_float(y);
}
__device__ __forceinline__ float wave_sum64(float v) {
    v = wave_dpp_add(v, 0); v = wave_dpp_add(v, 1); v = wave_dpp_add(v, 2); v = wave_dpp_add(v, 3);
    const int x = __float_as_int(v);
    return (__int_as_float(__builtin_amdgcn_readlane(x, 0)) + __int_as_float(__builtin_amdgcn_readlane(x, 16))) + (__int_as_float(__builtin_amdgcn_readlane(x, 32)) + __int_as_float(__builtin_amdgcn_readlane(x, 48)));
}
__device__ __forceinline__ void conf_phase(const Frame& F, const Args& a, int e, int zo) {
    const bf16* PB = (const bf16*)(a.ws + WS_PH); bf16* A2 = (bf16*)(a.ws + WS_A2);
    const float* dww = a.in[zo + 9] + (size_t)e * CK * CW; const float* dwb = a.in[zo + 10] + e * CW; const float* lnw = a.in[zo + 11] + e * CW; const float* lnb = a.in[zo + 12] + e * CW;
    LAS float* WL = (LAS float*)(F.lds + RING_OFF);
    { f32x4 wv[8];
#pragma unroll
      for (int q = 0; q < 8; ++q) { const int i = F.tid + q * NWAVES * 64; wv[q] = (i < CK * CW / 4) ? ((const f32x4*)dww)[i] : (f32x4){0.f, 0.f, 0.f, 0.f}; }
#pragma unroll
      for (int q = 0; q < 8; ++q) { const int i = F.tid + q * NWAVES * 64; ((LAS f32x4*)WL)[i] = wv[q]; } }
    __syncthreads();
    const int gw = F.vcu * NWAVES + F.wave, NGW = F.G * NWAVES, ch = 8 * F.lane;
    LAS unsigned char* US = F.lds + RING_OFF + (CK + 1) * CW * 4;
    for (int blk = F.vcu; blk < MP / 64; blk += F.G) {
        const int wrow0 = blk * 64, wt0 = wrow0 & (SEQ - 1), row0 = wrow0 + 8 * F.wave;
        f32x4 res[2][8];
#pragma unroll
        for (int ps = 0; ps < 2; ++ps) {
            const int c4 = 256 * ps + 4 * F.lane;
            __syncthreads();
            { v4u xx[6];
#pragma unroll
              for (int q = 0; q < 6; ++q) { const int idx = F.tid + q * NWAVES * 64, r = idx >> 5, c16 = idx & 31; int rr = wrow0 - 30 + r; rr = rr < wrow0 - wt0 ? wrow0 - wt0 : (rr > wrow0 + 63 ? wrow0 + 63 : rr);
                  xx[q] = *(const v4u*)(PB + (size_t)rr * 2560 + 2048 + 256 * ps + 8 * c16); }
#pragma unroll
              for (int q = 0; q < 6; ++q) { const int idx = F.tid + q * NWAVES * 64, r = idx >> 5, c16 = idx & 31; const bool ok = (r < 94) && (wt0 - 30 + r >= 0);
                  *(LAS v4u*)(US + r * 512 + 16 * c16) = ok ? xx[q] : (v4u){0u, 0u, 0u, 0u}; } }
            __syncthreads();
            f32x4 acc[8], sl[8];
#pragma unroll
            for (int i = 0; i < 8; ++i) { acc[i] = (f32x4){0.f, 0.f, 0.f, 0.f}; sl[i] = (f32x4){0.f, 0.f, 0.f, 0.f}; }
            const LAS unsigned char* up = US + (8 * F.wave) * 512 + 8 * F.lane; const LAS float* wp = WL + c4;
            v2u rwn0 = *(const LAS v2u*)up, rwn1 = *(const LAS v2u*)(up + 512);
            f32x4 wn0 = *(const LAS f32x4*)wp, wn1 = *(const LAS f32x4*)(wp + CW);
#pragma unroll 1
            for (int q = 0; q < 5; ++q) {
#pragma unroll
                for (int p = 0; p < 8; ++p) { const int r = 8 * q + p;
                    const v2u rw = rwn0; sl[p] = wn0; rwn0 = rwn1; wn0 = wn1;
                    { const int r2 = r + 2, ru = r2 < 39 ? r2 : 39, rwt = r2 < CK ? r2 : CK; rwn1 = *(const LAS v2u*)(up + ru * 512); wn1 = *(const LAS f32x4*)(wp + rwt * CW); }
                    const f32x4 uu = {pg8::bf_lo(rw.x), pg8::bf_hi(rw.x), pg8::bf_lo(rw.y), pg8::bf_hi(rw.y)};
#pragma unroll
                    for (int i = 0; i < 8; ++i) acc[i] += sl[(p - i) & 7] * uu; } }
            const f32x4 bb = *(const f32x4*)(dwb + c4);
#pragma unroll
            for (int i = 0; i < 8; ++i) res[ps][i] = acc[i] + bb;
        }
        const f32x4 w0 = *(const f32x4*)(lnw + 4 * F.lane), w1 = *(const f32x4*)(lnw + 256 + 4 * F.lane), c0 = *(const f32x4*)(lnb + 4 * F.lane), c1 = *(const f32x4*)(lnb + 256 + 4 * F.lane);
#pragma unroll
        for (int i = 0; i < 8; ++i) {
            const f32x4 x0 = res[0][i], x1 = res[1][i];
            const float mean = wave_sum64((x0[0] + x0[1]) + (x0[2] + x0[3]) + (x1[0] + x1[1]) + (x1[2] + x1[3])) * (1.f / CW);
            const f32x4 d0 = x0 - mean, d1 = x1 - mean;
            const float var = wave_sum64((d0[0] * d0[0] + d0[1] * d0[1]) + (d0[2] * d0[2] + d0[3] * d0[3]) + (d1[0] * d1[0] + d1[1] * d1[1]) + (d1[2] * d1[2] + d1[3] * d1[3])) * (1.f / CW);
            const float rs = rsqrtf(var + LN_EPS);
            f32x4 y0 = d0 * rs * w0 + c0, y1 = d1 * rs * w1 + c1;
#pragma unroll
            for (int j = 0; j < 4; ++j) { y0[j] = pg8::fsilu(y0[j]); y1[j] = pg8::fsilu(y1[j]); }
            bf16* op = A2 + (size_t)(row0 + i) * D + HW + 4 * F.lane;
            *(v2u*)op = (v2u){pk2(y0[0], y0[1]), pk2(y0[2], y0[3])}; *(v2u*)(op + 256) = (v2u){pk2(y1[0], y1[1]), pk2(y1[2], y1[3])}; }
    }
    __syncthreads();
}
__device__ __forceinline__ void conf_sample_token(const Frame& F, const Args& a, int e, int zo, int bs) {
    const bf16* PB = (const bf16*)(a.ws + WS_PH); bf16* A2 = (bf16*)(a.ws + WS_A2);
    const float* dww = a.in[zo + 9] + (size_t)e * CK * CW; const float* dwb = a.in[zo + 10] + e * CW; const float* lnw = a.in[zo + 11] + e * CW; const float* lnb = a.in[zo + 12] + e * CW;
    const float* cbuf = a.in[zo + 3] + ((size_t)e * DEC + bs) * 30 * CW;
    LAS float* PS = (LAS float*)(F.lds + RING_OFF);
    const int ch = 8 * F.lane;
    f32x4 h0[4], h1[4], w0[4], w1[4];
#pragma unroll
    for (int q = 0; q < 4; ++q) { const int j = F.wave + 8 * q;
        if (j < CK - 1) { h0[q] = __builtin_nontemporal_load((const f32x4*)(cbuf + (size_t)j * CW + ch)); h1[q] = __builtin_nontemporal_load((const f32x4*)(cbuf + (size_t)j * CW + ch + 4)); }
        else if (j == CK - 1) { const v4u raw = *(const v4u*)(PB + (size_t)(MP + bs) * 2560 + 2048 + ch);
            h0[q] = (f32x4){pg8::bf_lo(raw.x), pg8::bf_hi(raw.x), pg8::bf_lo(raw.y), pg8::bf_hi(raw.y)}; h1[q] = (f32x4){pg8::bf_lo(raw.z), pg8::bf_hi(raw.z), pg8::bf_lo(raw.w), pg8::bf_hi(raw.w)}; }
        else { h0[q] = (f32x4){0.f, 0.f, 0.f, 0.f}; h1[q] = h0[q]; }
        const int jw = j < CK ? j : 0; w0[q] = *(const f32x4*)(dww + (size_t)jw * CW + ch); w1[q] = *(const f32x4*)(dww + (size_t)jw * CW + ch + 4); }
    f32x4 p0 = {0.f, 0.f, 0.f, 0.f}, p1 = p0;
#pragma unroll
    for (int q = 0; q < 4; ++q) { p0 += w0[q] * h0[q]; p1 += w1[q] * h1[q]; }
    *(LAS f32x4*)(PS + F.wave * CW + ch) = p0; *(LAS f32x4*)(PS + F.wave * CW + ch + 4) = p1;
    __syncthreads();
    if (F.wave == 0) {
        f32x4 x0 = *(const f32x4*)(dwb + ch), x1 = *(const f32x4*)(dwb + ch + 4);
#pragma unroll
        for (int q = 0; q < 8; ++q) { x0 += *(const LAS f32x4*)(PS + q * CW + ch); x1 += *(const LAS f32x4*)(PS + q * CW + ch + 4); }
        const f32x4 g0 = *(const f32x4*)(lnw + ch), g1 = *(const f32x4*)(lnw + ch + 4), c0 = *(const f32x4*)(lnb + ch), c1 = *(const f32x4*)(lnb + ch + 4);
        const float mean = wave_sum64((x0[0] + x0[1]) + (x0[2] + x0[3]) + (x1[0] + x1[1]) + (x1[2] + x1[3])) * (1.f / CW);
        const f32x4 d0 = x0 - mean, d1 = x1 - mean;
        const float var = wave_sum64((d0[0] * d0[0] + d0[1] * d0[1]) + (d0[2] * d0[2] + d0[3] * d0[3]) + (d1[0] * d1[0] + d1[1] * d1[1]) + (d1[2] * d1[2] + d1[3] * d1[3])) * (1.f / CW);
        const float rs = rsqrtf(var + LN_EPS);
        f32x4 y0 = d0 * rs * g0 + c0, y1 = d1 * rs * g1 + c1;
#pragma unroll
        for (int j = 0; j < 4; ++j) { y0[j] = pg8::fsilu(y0[j]); y1[j] = pg8::fsilu(y1[j]); }
        { const v4u o_ = (v4u){pk2(y0[0], y0[1]), pk2(y0[2], y0[3]), pk2(y1[0], y1[1]), pk2(y1[2], y1[3])}; st16_wt(A2 + (size_t)(MP + bs) * D + HW + ch, __builtin_bit_cast(f32x4, o_)); }
    }
    __syncthreads();
}
__device__ __forceinline__ void hgrn_sample_phase(const Frame& F, const Args& a, int e, int zo) {
    const bf16* PB = (const bf16*)(a.ws + WS_PH); bf16* A2 = (bf16*)(a.ws + WS_A2);
    const float* S0all = a.in[zo + 2] + (size_t)e * DEC * NH * DK * DV; const float* gw = a.in[zo + 8] + e * DV;
    float* o_hs = a.out + (size_t)MT * D + (size_t)2 * NB * NH * DK * DV + (size_t)2 * NB * 30 * CW + (size_t)2 * NB * 2 * D + (size_t)e * DEC * NH * DK * DV;
    LAS float* RED = (LAS float*)(F.lds + RING_OFF);
    const int v4 = (F.tid & 31) * 4, kg = F.tid >> 5;
    for (int unit0 = F.vcu; unit0 < DEC * NH; unit0 += 2 * F.G) {
        f32x4 s0v[2][8], vv[2]; float qq[2][8], lf[2][8];
#pragma unroll
        for (int uu = 0; uu < 2; ++uu) { const int unit = unit0 + uu * F.G; if (unit < DEC * NH) { const int bs = unit >> 2, h = unit & 3;
            const bf16* pr = PB + (size_t)(MP + bs) * 2560 + h * 128; const float* S0 = S0all + (size_t)unit * 16384;
            const v2u vraw = *(const v2u*)(pr + 1024 + v4); vv[uu] = (f32x4){pg8::bf_lo(vraw.x), pg8::bf_hi(vraw.x), pg8::bf_lo(vraw.y), pg8::bf_hi(vraw.y)};
            const v4u qraw = *(const v4u*)(pr + kg * 8), lraw = *(const v4u*)(pr + 512 + kg * 8);
            qq[uu][0] = pg8::bf_lo(qraw.x); qq[uu][1] = pg8::bf_hi(qraw.x); qq[uu][2] = pg8::bf_lo(qraw.y); qq[uu][3] = pg8::bf_hi(qraw.y); qq[uu][4] = pg8::bf_lo(qraw.z); qq[uu][5] = pg8::bf_hi(qraw.z); qq[uu][6] = pg8::bf_lo(qraw.w); qq[uu][7] = pg8::bf_hi(qraw.w);
            lf[uu][0] = pg8::bf_lo(lraw.x); lf[uu][1] = pg8::bf_hi(lraw.x); lf[uu][2] = pg8::bf_lo(lraw.y); lf[uu][3] = pg8::bf_hi(lraw.y); lf[uu][4] = pg8::bf_lo(lraw.z); lf[uu][5] = pg8::bf_hi(lraw.z); lf[uu][6] = pg8::bf_lo(lraw.w); lf[uu][7] = pg8::bf_hi(lraw.w);
#pragma unroll
            for (int j = 0; j < 8; ++j) s0v[uu][j] = __builtin_nontemporal_load((const f32x4*)(S0 + (kg * 8 + j) * 128 + v4)); } }
#pragma unroll
        for (int uu = 0; uu < 2; ++uu) { const int unit = unit0 + uu * F.G; if (unit < DEC * NH) { const int bs = unit >> 2, h = unit & 3;
            const bf16* pr = PB + (size_t)(MP + bs) * 2560 + h * 128; float* Sn = o_hs + (size_t)unit * 16384;
            f32x4 part = {0.f, 0.f, 0.f, 0.f};
#pragma unroll
            for (int j = 0; j < 8; ++j) { const float f = __expf(lf[uu][j]); const f32x4 sx = s0v[uu][j] * f + vv[uu] * (1.f - f); st16_wt(Sn + (kg * 8 + j) * 128 + v4, sx); part += sx * qq[uu][j]; }
            *(LAS f32x4*)(RED + kg * 128 + v4) = part;
            __syncthreads();
            float o = 0.f;
            if (F.tid < 128) {
#pragma unroll
                for (int g = 0; g < 16; ++g) o += RED[g * 128 + F.tid];
                const float ss = wave_sum64(o * o);
                if (F.lane == 0) RED[2048 + F.wave] = ss; }
            __syncthreads();
            if (F.tid < 128) { const float sc = rsqrtf((RED[2048] + RED[2049]) * (1.f / DV) + RMS_EPS);
                st2_wt(A2 + (size_t)(MP + bs) * D + h * 128 + F.tid, f2bf(o * sc * gw[F.tid] * b2f(pr[1536 + F.tid]))); }
            __syncthreads(); } }
    }
}
__device__ __forceinline__ void sconv_phase(const Frame& F, const Args& a, int e, int zo) {
    const bf16* BGZ = (const bf16*)(a.ws + WS_PH); bf16* A2 = (bf16*)(a.ws + WS_A2);
    const float* cw = a.in[zo + 14] + (size_t)e * 3 * D;
    const int gw = F.vcu * NWAVES + F.wave, NGW = F.G * NWAVES;
    const bool xal = (NGW == MP / 8);
    for (int u = gw; u < (MP / 8) * 2; u += NGW) {
        const int half = xal ? (u >= NGW ? 1 : 0) : (u & 1), row0 = (xal ? (u - half * NGW) : (u >> 1)) * 8, t0 = row0 & (SEQ - 1), ch = half * 512 + 8 * F.lane;
        f32x4 wq[3][2];
#pragma unroll
        for (int j = 0; j < 3; ++j) { wq[j][0] = *(const f32x4*)(cw + j * D + ch); wq[j][1] = *(const f32x4*)(cw + j * D + ch + 4); }
        f32x4 z[10][2];
#pragma unroll
        for (int r = 0; r < 10; ++r) { z[r][0] = (f32x4){0.f, 0.f, 0.f, 0.f}; z[r][1] = z[r][0];
            if (t0 - 2 + r >= 0) { const v4u raw = *(const v4u*)(BGZ + (size_t)(row0 - 2 + r) * 2048 + 1024 + ch);
                z[r][0] = (f32x4){pg8::bf_lo(raw.x), pg8::bf_hi(raw.x), pg8::bf_lo(raw.y), pg8::bf_hi(raw.y)}; z[r][1] = (f32x4){pg8::bf_lo(raw.z), pg8::bf_hi(raw.z), pg8::bf_lo(raw.w), pg8::bf_hi(raw.w)}; } }
        v4u graw[8];
#pragma unroll
        for (int i = 0; i < 8; ++i) graw[i] = *(const v4u*)(BGZ + (size_t)(row0 + i) * 2048 + ch);
#pragma unroll
        for (int i = 0; i < 8; ++i) { const v4u raw = graw[i];
            const f32x4 g0 = {pg8::bf_lo(raw.x), pg8::bf_hi(raw.x), pg8::bf_lo(raw.y), pg8::bf_hi(raw.y)}, g1 = {pg8::bf_lo(raw.z), pg8::bf_hi(raw.z), pg8::bf_lo(raw.w), pg8::bf_hi(raw.w)};
            const f32x4 y0 = g0 * (wq[0][0] * z[i][0] + wq[1][0] * z[i + 1][0] + wq[2][0] * z[i + 2][0]), y1 = g1 * (wq[0][1] * z[i][1] + wq[1][1] * z[i + 1][1] + wq[2][1] * z[i + 2][1]);
            { const v4u o_ = (v4u){pk2(y0[0], y0[1]), pk2(y0[2], y0[3]), pk2(y1[0], y1[1]), pk2(y1[2], y1[3])}; st16_wt(A2 + (size_t)(row0 + i) * D + ch, __builtin_bit_cast(f32x4, o_)); } }
    }
    const float* sbuf = a.in[zo + 4] + (size_t)e * DEC * 2 * D;
    for (int u = gw; u < DEC * 2; u += NGW) { const int half = u & 1, bs = u >> 1, ch = half * 512 + 8 * F.lane, row = MP + bs;
        const v4u zr = *(const v4u*)(BGZ + (size_t)row * 2048 + 1024 + ch), gr = *(const v4u*)(BGZ + (size_t)row * 2048 + ch);
        const f32x4 z0 = {pg8::bf_lo(zr.x), pg8::bf_hi(zr.x), pg8::bf_lo(zr.y), pg8::bf_hi(zr.y)}, z1 = {pg8::bf_lo(zr.z), pg8::bf_hi(zr.z), pg8::bf_lo(zr.w), pg8::bf_hi(zr.w)};
        const f32x4 g0 = {pg8::bf_lo(gr.x), pg8::bf_hi(gr.x), pg8::bf_lo(gr.y), pg8::bf_hi(gr.y)}, g1 = {pg8::bf_lo(gr.z), pg8::bf_hi(gr.z), pg8::bf_lo(gr.w), pg8::bf_hi(gr.w)};
        const float* h0 = sbuf + ((size_t)bs * 2 + 0) * D + ch; const float* h1 = sbuf + ((size_t)bs * 2 + 1) * D + ch;
        const f32x4 y0 = g0 * (*(const f32x4*)(cw + ch) * *(const f32x4*)h0 + *(const f32x4*)(cw + D + ch) * *(const f32x4*)h1 + *(const f32x4*)(cw + 2 * D + ch) * z0);
        const f32x4 y1 = g1 * (*(const f32x4*)(cw + ch + 4) * *(const f32x4*)(h0 + 4) + *(const f32x4*)(cw + D + ch + 4) * *(const f32x4*)(h1 + 4) + *(const f32x4*)(cw + 2 * D + ch + 4) * z1);
        { const v4u o_ = (v4u){pk2(y0[0], y0[1]), pk2(y0[2], y0[3]), pk2(y1[0], y1[1]), pk2(y1[2], y1[3])}; st16_wt(A2 + (size_t)row * D + ch, __builtin_bit_cast(f32x4, o_)); } }
}
__device__ __forceinline__ void p_even_mixer1(const Frame& F0, const Args& a, int e, int zo) {
    const Frame F = phase_frame(F0);
    hgrn_pass1(F, a.ws);
    conf_phase(F, a, e, zo);
}
__device__ __forceinline__ void p_even_mixer2(const Frame& F0, const Args& a, int e, int zo) {
    const Frame F = phase_frame(F0);
    hgrn_pass2(F, a.ws, a.in[zo + 8] + e * DV, a.out + (size_t)MT * D + (size_t)e * NB * NH * DK * DV);
    for (int u = F.vcu; u < 256; u += F.G) if ((u & 7) < 4) conf_sample_token(F, a, e, zo, (u >> 3) * 4 + (u & 7));
    hgrn_sample_phase(F, a, e, zo);
}
__device__ __forceinline__ void p_odd_mixer(const Frame& F0, const Args& a, int e, int zo) {
    const Frame F = phase_frame(F0);
    sconv_phase(F, a, e, zo);
}
__device__ __forceinline__ int bx_now() { int b = (int)blockIdx.x; asm volatile("" : "+s"(b)); return b; }
__device__ __forceinline__ const float* stats_ptr(const unsigned char* ws, int i) { return (const float*)(ws + (i == 0 ? WS_STATS0 : WS_STATS + (size_t)(i - 1) * STATS_BYTES)); }
__global__ void __launch_bounds__(NWAVES * 64, 2) mk_fwd(Args args) {
    extern __shared__ __attribute__((aligned(16))) unsigned char lds[];
    Frame F;
    F.lds = (LAS unsigned char*)lds;
    F.tid = threadIdx.x; F.lane = F.tid & 63; F.wave = __builtin_amdgcn_readfirstlane(F.tid >> 6);
    F.G = gridDim.x; { const int bx = blockIdx.x; F.vcu = (F.G % 8 == 0) ? (bx % 8) * (F.G / 8) + bx / 8 : bx; }
    unsigned char* ws = args.ws;
    gu32* ctl = (gu32*)(ws + WS_CTL);
    for (int u = F.tid; u < (LDS_BYTES - LDSCTL_OFF) / 4; u += NWAVES * 64) ((LAS unsigned*)(F.lds + LDSCTL_OFF))[u] = 0u;
    __syncthreads();
    XcdBarrier bar; bar.bar = (unsigned*)(ctl + CW_BAR) + args.li * XCD_BAR_WORDS; bar.x = 0; bar.st = nullptr;
    bar = xcd_barrier_post((unsigned*)(ctl + CW_BAR) + args.li * XCD_BAR_WORDS, (volatile LAS unsigned*)(F.lds + MISC_OFF) + 8);
    if (threadIdx.x == 0) ctl[CW_XID + blockIdx.x] = xb_xcc_id() + 1u;
#define IN(k) true
#define SEAM(k) do { XcdBarrier _b; _b.bar = (unsigned*)(args.ws + WS_CTL) + CW_BAR; _b.x = xb_xcc_id(); _b.st = (volatile LAS unsigned*)(F.lds + MISC_OFF) + 8; xcd_barrier(_b); } while (0)
    bf16* Za = (bf16*)(ws + WS_ZA); bf16* Zb = (bf16*)(ws + WS_ZB); bf16* A2 = (bf16*)(ws + WS_A2); bf16* PH = (bf16*)(ws + WS_PH);
    float* out = args.out;
    float* o_hp = out + (size_t)MT * D; float* o_cp = o_hp + (size_t)2 * NB * NH * DK * DV; float* o_sp = o_cp + (size_t)2 * NB * 30 * CW;
    float* o_hs = o_sp + (size_t)2 * NB * 2 * D; float* o_cs = o_hs + (size_t)2 * DEC * NH * DK * DV; float* o_ss = o_cs + (size_t)2 * DEC * 30 * CW;

    if (IN(0)) { p0_prologue(F, args); SEAM(0); }
    if (F.wave == 0) { const int j_ = (int)(blockIdx.x & 7u) + 8 * (F.lane & 31);
        const unsigned id_ = (F.G == 256) ? ctl[CW_XID + j_] : 0u;
        if (__builtin_amdgcn_ballot_w64(id_ != xb_xcc_id() + 1u) != 0ull && F.lane == 0) (void)__hip_atomic_fetch_or((unsigned*)(args.ws + WS_CTL) + CW_NONLOC, 1u, __ATOMIC_RELAXED, __HIP_MEMORY_SCOPE_AGENT); }
#define SEAM_LT(k) do { XcdBarrier _b; _b.bar = (unsigned*)(args.ws + WS_CTL) + CW_BAR; _b.x = xb_xcc_id(); _b.st = (volatile LAS unsigned*)(F.lds + MISC_OFF) + 8; xcd_barrier_light(_b, (const unsigned*)(args.ws + WS_CTL) + CW_NONLOC); } while (0)
#define SEAM_L(k) do { XcdBarrier _b; _b.bar = (unsigned*)(args.ws + WS_CTL) + CW_BAR; _b.x = xb_xcc_id(); _b.st = (volatile LAS unsigned*)(F.lds + MISC_OFF) + 8; \
        xcd_seam_local(_b, (unsigned*)(args.ws + WS_CTL) + CW_XLOC + 64 * _b.x, (const unsigned*)(args.ws + WS_CTL) + CW_NONLOC); } while (0)
    for (int l = 0; l < 4; ++l) {
        int zo; asm volatile("s_mov_b32 %0, 0" : "=s"(zo));
        const int pb = 1 + 6 * l, e = l >> 1;
        const unsigned char* wl = ws + WS_W + (size_t)l * W_LAYER;
        const float* cv = (const float*)(ws + WS_CVEC) + (size_t)l * CVEC_LAYER;
        if (IN(pb)) {
            pg8::Gemm g{Za, (const bf16*)(wl + W_IN), MP, EIN, D}; pg8::StaticOrder S; S.init(MP, EIN, F.G, bx_now());

            int l_a = l; asm volatile("" : "+s"(l_a));
            pg8::LnIn ln{stats_ptr(ws, 2 * l_a), cv, cv + EIN};
            if ((l & 1) == 0) { pg8::EpiEvenIn E{ln, PH, (const float*)(ws + WS_LBS) + e * HW, o_cp + (size_t)e * NB * 30 * CW, o_cs + (size_t)e * DEC * 30 * CW};
                pg8::gemm_phase<pg8::EpiEvenIn, pg8::StaticOrder, true, true>(F.lds + RING_OFF, g, S, E, F.wave);
                { int Gq = F.G; asm volatile("" : "+s"(Gq)); const int nmu = g.N >> 5, mfirst = (nmu <= Gq / 2 || Gq < 256) ? (Gq - nmu > 0 ? Gq - nmu : 0) : Gq / 2; for (int mu = (int)blockIdx.x - mfirst; mu >= 0 && mu < nmu; mu += Gq - mfirst) pg8::mini_ring(F.lds + RING_OFF, g.A, g.Bt, g.K, E, mu, F.wave);
                  if (l == 0) { const int w2s = (F.G == 256) ? P_IW2 : 0; if (mfirst > 0) { if ((int)blockIdx.x < mfirst) p_convert_tail(F, args, P_IIN, P_ILAYER - w2s, (int)blockIdx.x, mfirst); } else p_convert_tail(F, args, P_IIN, P_ILAYER - w2s, (int)blockIdx.x, F.G); } } }
            else { pg8::EpiOddIn E{ln, PH, o_sp + (size_t)e * NB * 2 * D, o_ss + (size_t)e * DEC * 2 * D};
                pg8::gemm_phase<pg8::EpiOddIn, pg8::StaticOrder, true, true>(F.lds + RING_OFF, g, S, E, F.wave);
                { int Gq = F.G; asm volatile("" : "+s"(Gq)); const int nmu = g.N >> 5, mfirst = (nmu <= Gq / 2 || Gq < 256) ? (Gq - nmu > 0 ? Gq - nmu : 0) : Gq / 2; for (int mu = (int)blockIdx.x - mfirst; mu >= 0 && mu < nmu; mu += Gq - mfirst) pg8::mini_ring(F.lds + RING_OFF, g.A, g.Bt, g.K, E, mu, F.wave); } }
            if (l == 0) SEAM(pb); else SEAM_LT(pb);
        }
        if (IN(pb + 1)) { if ((l & 1) == 0) p_even_mixer1(F, args, e, zo); else p_odd_mixer(F, args, e, zo); SEAM_L(pb + 1); }
        if (IN(pb + 2) && (l & 1) == 0) { p_even_mixer2(F, args, e, zo); SEAM_L(pb + 2); }
        if (IN(pb + 3)) {
            pg8::Gemm g{A2, (const bf16*)(wl + W_OUT), MP, D, D}; pg8::StaticOrder S; S.init(MP, D, F.G, bx_now());
            int l_b = l; asm volatile("" : "+s"(l_b));
            pg8::EpiRes<false> E{Za, stats_ptr(ws, 2 * l_b), l_b > 0 ? args.in[zo + 21] + (size_t)(l_b - 1) * D : (const float*)(ws + WS_ONES), l_b > 0 ? args.in[zo + 22] + (size_t)(l_b - 1) * D : (const float*)(ws + WS_ZEROS),
                                 Zb, nullptr, (float*)stats_ptr(ws, 2 * l + 1)};
            pg8::gemm_phase<pg8::EpiRes<false>, pg8::StaticOrder, true, true>(F.lds + RING_OFF, g, S, E, F.wave);
            SEAM_LT(pb + 3);
        }
        if (IN(pb + 4)) {
            unsigned* sctr = (unsigned*)(ctl + CW_SCTR) + 64 * l;
            {
                int l_c = l; asm volatile("" : "+s"(l_c));
                pg8::EpiRes<false> Eo{Za, stats_ptr(ws, 2 * l_c), l_c > 0 ? args.in[zo + 21] + (size_t)(l_c - 1) * D : (const float*)(ws + WS_ONES), l_c > 0 ? args.in[zo + 22] + (size_t)(l_c - 1) * D : (const float*)(ws + WS_ZEROS),
                                      Zb, nullptr, (float*)stats_ptr(ws, 2 * l + 1)};
                const int nmo = D >> 5, mfo = F.G > nmo ? F.G - nmo : 0; unsigned ndone = 0u;
                for (int mu = (int)blockIdx.x - mfo; mu >= 0 && mu < nmo; mu += F.G - mfo) { pg8::mini_ring(F.lds + RING_OFF, A2, (const bf16*)(wl + W_OUT), D, Eo, mu, F.wave); ++ndone; }
                if (ndone) sample_publish(F, sctr, ndone);
            }
            pg8::Gemm g{Zb, (const bf16*)(wl + W_13), MP, NUP, D}; pg8::StaticOrder S; S.init(MP, NUP, F.G, bx_now());
            pg8::EpiUp E{pg8::LnIn{stats_ptr(ws, 2 * l + 1), cv + 2 * EIN, cv + 2 * EIN + NUP}, PH};
            pg8::gemm_phase<pg8::EpiUp, pg8::StaticOrder, true, true>(F.lds + RING_OFF, g, S, E, F.wave);
            { int Gq = F.G; asm volatile("" : "+s"(Gq)); const int nmu = g.N >> 5, mfirst = (nmu <= Gq / 2 || Gq < 256) ? (Gq - nmu > 0 ? Gq - nmu : 0) : Gq / 2;
              const int mfo2 = F.G > (D >> 5) ? F.G - (D >> 5) : 0, uhi = (mfo2 > mfirst && 2 * (mfo2 - mfirst) >= nmu) ? mfo2 : F.G;
              if ((int)blockIdx.x >= mfirst && (int)blockIdx.x < uhi) { sample_wait(F, sctr, (unsigned)(D >> 5));
                  for (int mu = (int)blockIdx.x - mfirst; mu >= 0 && mu < nmu; mu += uhi - mfirst) pg8::mini_ring(F.lds + RING_OFF, g.A, g.Bt, g.K, E, mu, F.wave); } }
            if (F.G == 256 && (int)blockIdx.x >= 128) { const int wi = (int)blockIdx.x - 128;
                if (l == 0) p_convert_tail(F, args, P_ILAYER - P_IW2, P_ILAYER, wi, 128);
                if (l < 3) { const int xs = (l == 0) ? 768 : 1792; p_convert_tail(F, args, (l + 2) * P_ILAYER - xs, (l + 2) * P_ILAYER, wi, 128); } }
            SEAM_LT(pb + 4);
        }
        if (IN(pb + 5)) {
            pg8::Gemm g{PH, (const bf16*)(wl + W_2), MP, D, DFF}; pg8::StaticOrder S; S.init(MP, D, F.G, bx_now());

            { pg8::EpiRes<false> E{Zb, stats_ptr(ws, 2 * l + 1), args.in[zo + 19] + (size_t)l * D, args.in[zo + 20] + (size_t)l * D, Za, nullptr, (float*)stats_ptr(ws, 2 * l + 2)};
                pg8::gemm_phase<pg8::EpiRes<false>, pg8::StaticOrder, true, true>(F.lds + RING_OFF, g, S, E, F.wave);
                { int Gq = F.G; asm volatile("" : "+s"(Gq)); const int nmu = g.N >> 5, mfirst = (nmu <= Gq / 2 || Gq < 256) ? (Gq - nmu > 0 ? Gq - nmu : 0) : Gq / 2; for (int mu = (int)blockIdx.x - mfirst; mu >= 0 && mu < nmu; mu += Gq - mfirst) pg8::mini_ring(F.lds + RING_OFF, g.A, g.Bt, g.K, E, mu, F.wave);
                  if (l < 3) { if (mfirst > 0) { if ((int)blockIdx.x < mfirst) { p_convert_tail(F, args, (l + 1) * P_ILAYER, (l + 2) * P_ILAYER - ((F.G == 256) ? (l == 0 ? 768 : 1792) : 0), (int)blockIdx.x, mfirst); if (l == 0) p_state_copies_tail(F, args, (int)blockIdx.x, mfirst); } }
                  else { p_convert_tail(F, args, (l + 1) * P_ILAYER, (l + 2) * P_ILAYER - ((F.G == 256) ? (l == 0 ? 768 : 1792) : 0), (int)blockIdx.x, F.G); if (l == 0) p_state_copies_tail(F, args, (int)blockIdx.x, F.G); } } } }
            if (l < 3) SEAM_LT(pb + 5); else SEAM(pb + 5);
        }
    }
    if (IN(25)) p_final_ln(F, args);
#undef IN
#undef SEAM
}
extern "C" void kernel_launch(void* const* d_in, const int* in_sizes, int n_in, void* d_out, int out_size, void* d_ws, size_t ws_size, hipStream_t stream) {
    static int grid = 0;
    if (grid == 0) {
        if (n_in != 23 || ws_size < WS_END) { fprintf(stderr, "kernel_launch: built for 23 inputs and >= %zu bytes of workspace; got n_in %d, ws %zu; nothing launched\n", (size_t)WS_END, n_in, ws_size); grid = -1; return; }
        int dev = 0, cus = 0;
        if (hipGetDevice(&dev) != hipSuccess || hipDeviceGetAttribute(&cus, hipDeviceAttributeMultiprocessorCount, dev) != hipSuccess) { grid = -1; return; }
        if (hipFuncSetAttribute((const void*)mk_fwd, hipFuncAttributeMaxDynamicSharedMemorySize, LDS_BYTES) != hipSuccess) { fprintf(stderr, "kernel_launch: hipFuncSetAttribute failed\n"); grid = -1; return; }
        grid = cus;
    }
    if (grid < 0) return;
    hipMemsetAsync((char*)d_ws + WS_CTL, 0, CTL_ZERO_BYTES, stream);
    Args a{};
    for (int i = 0; i < 23; ++i) a.in[i] = (const float*)d_in[i];
    a.out = (float*)d_out; a.ws = (unsigned char*)d_ws;
    int li = 0;
    auto run = [&](int lo, int hi) { a.ph_lo = lo; a.ph_hi = hi; a.li = li++; hipLaunchKernelGGL(mk_fwd, dim3(grid), dim3(NWAVES * 64), LDS_BYTES, stream, a); };
    run(0, 26);
}
```
